# Optimizing an MI355X kernel written in HIP

```python
import jax, jax.numpy as jnp
from jax import lax
import numpy as np

D_MODEL = 1024
BATCH = 8
SEQ = 2048
DEPTH = 2

HEAD_DIM = 64
FOX_HEADS = 6
SB_HEADS = 6
MLA_HEADS = 4
MLA_Q_RANK = 256
MLA_KV_RANK = 128
MLA_NOPE_DIM = 64
MLA_ROPE_DIM = 32
MLA_V_DIM = 64
ROPE_THETA = 10000.0
FOX_WIDTH = FOX_HEADS * HEAD_DIM
SB_WIDTH = SB_HEADS * HEAD_DIM
MLA_WIDTH = MLA_HEADS * MLA_V_DIM
MIX_WIDTH = FOX_WIDTH + MLA_WIDTH + SB_WIDTH
Q_BLOCK = 128
IN_SPLITS = (FOX_WIDTH, FOX_WIDTH, FOX_WIDTH, FOX_HEADS,
             MLA_Q_RANK, MLA_KV_RANK, MLA_ROPE_DIM,
             SB_WIDTH, SB_WIDTH, SB_WIDTH)
IN_COLS = sum(IN_SPLITS)

PEER_HEADS = 8
PEER_N_KEYS = 128
PEER_N_EXPERTS = PEER_N_KEYS * PEER_N_KEYS
PEER_TOPK = 16
PEER_QUERY_DIM = 256
PEER_HALF = PEER_QUERY_DIM // 2
PEER_CHUNK = 128

NORM_EPS = 1e-6

kernel_name = "hybrid_fox_mla_stickbreak_peer"


def rms_norm(x, g):
    xf = x.astype(jnp.float32)
    y = xf * lax.rsqrt(jnp.mean(xf * xf, axis=-1, keepdims=True) + NORM_EPS)
    return (y * g.astype(jnp.float32)).astype(x.dtype)


def _heads(a, n):
    b, s, _ = a.shape
    return a.reshape(b, s, n, -1).transpose(0, 2, 1, 3)


def _q_block(a, i):
    return lax.dynamic_slice_in_dim(a, i * Q_BLOCK, Q_BLOCK, axis=2)


def _sweep(block_fn, seq):
    outs = lax.map(block_fn, jnp.arange(seq // Q_BLOCK))
    nb, b, h, qb, d = outs.shape
    return outs.transpose(1, 0, 3, 2, 4).reshape(b, nb * qb, h * d)


def rope(x, pos):
    half = x.shape[-1] // 2
    inv_freq = 1.0 / (ROPE_THETA ** (jnp.arange(half, dtype=jnp.float32) / half))
    ang = pos[:, None] * inv_freq[None, :]
    cos, sin = jnp.cos(ang), jnp.sin(ang)
    xf = x.astype(jnp.float32)
    x1, x2 = xf[..., :half], xf[..., half:]
    return jnp.concatenate([x1 * cos - x2 * sin, x1 * sin + x2 * cos], axis=-1).astype(x.dtype)


def forgetting_attention(q, k, v, log_f):
    seq = q.shape[2]
    scale = HEAD_DIM ** -0.5
    c = jnp.cumsum(log_f.astype(jnp.float32), axis=-1)
    s_idx = jnp.arange(seq)

    def block(i):
        qb = _q_block(q, i)
        cb = lax.dynamic_slice_in_dim(c, i * Q_BLOCK, Q_BLOCK, axis=2)
        t_idx = i * Q_BLOCK + jnp.arange(Q_BLOCK)
        logits = (jnp.einsum('bhqd,bhkd->bhqk', qb, k, preferred_element_type=jnp.float32) * scale
                  + cb[..., :, None] - c[..., None, :])
        mask = s_idx[None, :] <= t_idx[:, None]
        p = jax.nn.softmax(jnp.where(mask, logits, -jnp.inf), axis=-1)
        return jnp.einsum('bhqk,bhkd->bhqd', p.astype(v.dtype), v)

    return _sweep(block, seq)


def latent_attention(q_nope, q_rope, k_nope, k_rope, v):
    seq = q_nope.shape[2]
    scale = (MLA_NOPE_DIM + MLA_ROPE_DIM) ** -0.5
    s_idx = jnp.arange(seq)

    def block(i):
        qn, qr = _q_block(q_nope, i), _q_block(q_rope, i)
        t_idx = i * Q_BLOCK + jnp.arange(Q_BLOCK)
        logits = (jnp.einsum('bhqd,bhkd->bhqk', qn, k_nope, preferred_element_type=jnp.float32)
                  + jnp.einsum('bhqd,bkd->bhqk', qr, k_rope, preferred_element_type=jnp.float32)) * scale
        mask = s_idx[None, :] <= t_idx[:, None]
        p = jax.nn.softmax(jnp.where(mask, logits, -jnp.inf), axis=-1)
        return jnp.einsum('bhqk,bhkd->bhqd', p.astype(v.dtype), v)

    return _sweep(block, seq)


def stick_breaking_attention(q, k, v):
    seq = q.shape[2]
    scale = HEAD_DIM ** -0.5
    s_idx = jnp.arange(seq)

    def block(i):
        qb = _q_block(q, i)
        t_idx = i * Q_BLOCK + jnp.arange(Q_BLOCK)
        z = jnp.einsum('bhqd,bhkd->bhqk', qb, k, preferred_element_type=jnp.float32) * scale
        mask = s_idx[None, :] < t_idx[:, None]
        log_keep = jnp.where(mask, jax.nn.log_sigmoid(-z), 0.0)
        later = lax.cumsum(log_keep, axis=3, reverse=True) - log_keep
        weight = jnp.where(mask, jnp.exp(jax.nn.log_sigmoid(z) + later), 0.0)
        return jnp.einsum('bhqk,bhkd->bhqd', weight.astype(v.dtype), v)

    return _sweep(block, seq)


def hybrid_mixer(h, w_in, fgate_b, q_norm_g, w_uq, kv_norm_g, w_ukv,
                 out_norm_fox, out_norm_mla, out_norm_sb, w_out):
    b, s, _ = h.shape
    proj = h @ w_in
    parts, off = [], 0
    for n in IN_SPLITS:
        parts.append(proj[..., off:off + n])
        off += n
    fq, fk, fv, f_logit, c_q, c_kv, k_rope_raw, sq, sk, sv = parts
    pos = jnp.arange(s, dtype=jnp.float32)

    log_f = jax.nn.log_sigmoid((f_logit + fgate_b).astype(jnp.float32)).transpose(0, 2, 1)
    y_fox = forgetting_attention(_heads(fq, FOX_HEADS), _heads(fk, FOX_HEADS), _heads(fv, FOX_HEADS), log_f)

    q_up = _heads(rms_norm(c_q, q_norm_g) @ w_uq, MLA_HEADS)
    q_nope, q_rope = q_up[..., :MLA_NOPE_DIM], rope(q_up[..., MLA_NOPE_DIM:], pos)
    kv_up = _heads(rms_norm(c_kv, kv_norm_g) @ w_ukv, MLA_HEADS)
    k_nope, v_mla = kv_up[..., :MLA_NOPE_DIM], kv_up[..., MLA_NOPE_DIM:]
    k_rope = rope(k_rope_raw, pos)
    y_mla = latent_attention(q_nope, q_rope, k_nope, k_rope, v_mla)

    y_sb = stick_breaking_attention(_heads(sq, SB_HEADS), _heads(sk, SB_HEADS), _heads(sv, SB_HEADS))

    y = jnp.concatenate([rms_norm(y_fox.astype(h.dtype), out_norm_fox),
                         rms_norm(y_mla.astype(h.dtype), out_norm_mla),
                         rms_norm(y_sb.astype(h.dtype), out_norm_sb)], axis=-1)
    return y @ w_out


def peer_ffn(h, w_query, keys1, keys2, u, v):
    b, s, d = h.shape
    t = b * s
    xt = h.reshape(t, d)
    q = (xt @ w_query).reshape(t, PEER_HEADS, PEER_QUERY_DIM)
    s1 = jnp.einsum('thd,kd->thk', q[..., :PEER_HALF], keys1, preferred_element_type=jnp.float32)
    s2 = jnp.einsum('thd,kd->thk', q[..., PEER_HALF:], keys2, preferred_element_type=jnp.float32)
    top1, idx1 = lax.top_k(s1, PEER_TOPK)
    top2, idx2 = lax.top_k(s2, PEER_TOPK)
    cand_score = (top1[..., :, None] + top2[..., None, :]).reshape(t, PEER_HEADS, PEER_TOPK * PEER_TOPK)
    cand_id = (idx1[..., :, None] * PEER_N_KEYS + idx2[..., None, :]).reshape(t, PEER_HEADS, PEER_TOPK * PEER_TOPK)
    best, pos = lax.top_k(cand_score, PEER_TOPK)
    expert_id = jnp.take_along_axis(cand_id, pos, axis=-1)
    gates = jax.nn.softmax(best, axis=-1)

    n_chunks = t // PEER_CHUNK
    xc = xt.reshape(n_chunks, PEER_CHUNK, d)
    idc = expert_id.reshape(n_chunks, PEER_CHUNK, PEER_HEADS, PEER_TOPK)
    gc = gates.reshape(n_chunks, PEER_CHUNK, PEER_HEADS, PEER_TOPK)

    def chunk(args):
        xi, ids, g = args
        act = jnp.einsum('cd,chkd->chk', xi, u[ids], preferred_element_type=jnp.float32)
        a = jax.nn.gelu(act, approximate=False) * g
        return jnp.einsum('chk,chkd->cd', a.astype(v.dtype), v[ids])

    return lax.map(chunk, (xc, idc, gc)).reshape(b, s, d)


def setup_inputs(seed: int = 0) -> dict:
    key = jax.random.key(seed)
    ks = jax.random.split(key, 20)
    f32 = jnp.float32

    def nrm(k, shape, scale):
        return jax.random.normal(k, shape, f32) * scale

    def gain(k, shape):
        return 1.0 + 0.02 * jax.random.normal(k, shape, f32)

    return {
        "x": nrm(ks[0], (BATCH, SEQ, D_MODEL), 1.0),
        "attn_norm_g": gain(ks[1], (DEPTH, D_MODEL)),
        "w_in": nrm(ks[2], (DEPTH, D_MODEL, IN_COLS), D_MODEL ** -0.5),
        "fgate_b": 3.0 + 0.1 * jax.random.normal(ks[3], (DEPTH, FOX_HEADS), f32),
        "mla_q_norm_g": gain(ks[4], (DEPTH, MLA_Q_RANK)),
        "w_uq": nrm(ks[5], (DEPTH, MLA_Q_RANK, MLA_HEADS * (MLA_NOPE_DIM + MLA_ROPE_DIM)), MLA_Q_RANK ** -0.5),
        "mla_kv_norm_g": gain(ks[6], (DEPTH, MLA_KV_RANK)),
        "w_ukv": nrm(ks[7], (DEPTH, MLA_KV_RANK, MLA_HEADS * (MLA_NOPE_DIM + MLA_V_DIM)), MLA_KV_RANK ** -0.5),
        "out_norm_fox": gain(ks[8], (DEPTH, FOX_WIDTH)),
        "out_norm_mla": gain(ks[9], (DEPTH, MLA_WIDTH)),
        "out_norm_sb": gain(ks[10], (DEPTH, SB_WIDTH)),
        "w_out": nrm(ks[11], (DEPTH, MIX_WIDTH, D_MODEL), MIX_WIDTH ** -0.5),
        "ffn_norm_g": gain(ks[12], (DEPTH, D_MODEL)),
        "peer_w_query": nrm(ks[13], (DEPTH, D_MODEL, PEER_HEADS * PEER_QUERY_DIM), D_MODEL ** -0.5),
        "peer_keys1": nrm(ks[14], (DEPTH, PEER_N_KEYS, PEER_HALF), PEER_HALF ** -0.5),
        "peer_keys2": nrm(ks[15], (DEPTH, PEER_N_KEYS, PEER_HALF), PEER_HALF ** -0.5),
        "peer_u": nrm(ks[16], (DEPTH, PEER_N_EXPERTS, D_MODEL), D_MODEL ** -0.5),
        "peer_v": nrm(ks[17], (DEPTH, PEER_N_EXPERTS, D_MODEL), PEER_HEADS ** -0.5),
        "final_norm_g": gain(ks[18], (D_MODEL,)),
    }


def reference(x, attn_norm_g, w_in, fgate_b, mla_q_norm_g, w_uq, mla_kv_norm_g, w_ukv,
              out_norm_fox, out_norm_mla, out_norm_sb, w_out, ffn_norm_g, peer_w_query,
              peer_keys1, peer_keys2, peer_u, peer_v, final_norm_g):
    for l in range(DEPTH):
        h = rms_norm(x, attn_norm_g[l])
        x = x + hybrid_mixer(h, w_in[l], fgate_b[l], mla_q_norm_g[l], w_uq[l], mla_kv_norm_g[l],
                             w_ukv[l], out_norm_fox[l], out_norm_mla[l], out_norm_sb[l], w_out[l])
        h = rms_norm(x, ffn_norm_g[l])
        x = x + peer_ffn(h, peer_w_query[l], peer_keys1[l], peer_keys2[l], peer_u[l], peer_v[l])
    return rms_norm(x, final_norm_g)
```

```cpp
#include <hip/hip_runtime.h>
#include <hip/hip_bf16.h>
#include <cstdio>
#include <cstdint>
#include <cmath>

namespace nv {
constexpr int B = 8, S = 2048, D = 1024, M = B * S, INC = 2726;
constexpr float EPS = 1e-6f;

__device__ __forceinline__ float wsum(float v) {
#pragma unroll
    for (int o = 32; o >= 1; o >>= 1) v += __shfl_xor(v, o);
    return v;
}
__device__ __forceinline__ float logsig(float x) { return fminf(x, 0.f) - log1pf(expf(-fabsf(x))); }

__global__ void __launch_bounds__(256) rmsnorm(const float* x, int ldx, const float* g, float* out, int ldo, int rows, int width) {
    const int gw = (blockIdx.x * 256 + threadIdx.x) >> 6, lane = threadIdx.x & 63;
    if (gw >= rows) return;
    const float* xr = x + (size_t)gw * ldx; float* orow = out + (size_t)gw * ldo;
    float v[16]; float s = 0.f;
#pragma unroll
    for (int j = 0; j < 16; ++j) { const int c = j * 64 + lane; v[j] = (c < width) ? xr[c] : 0.f; s += v[j] * v[j]; }
    s = wsum(s);
    const float r = rsqrtf(s / (float)width + EPS);
#pragma unroll
    for (int j = 0; j < 16; ++j) { const int c = j * 64 + lane; if (c < width) orow[c] = v[j] * r * g[c]; }
}

__global__ void __launch_bounds__(256) gemm(const float* A, int lda, const float* Bm, int ldb, float* C, int ldc, const float* R, int ldr, int Mr, int N, int K) {
    __shared__ float As[16][64 + 4];
    __shared__ float Bs[16][64 + 4];
    const int tid = threadIdx.x, tx = tid & 15, ty = tid >> 4;
    const int m0 = blockIdx.y * 64, n0 = blockIdx.x * 64;
    float acc[4][4];
#pragma unroll
    for (int i = 0; i < 4; ++i)
#pragma unroll
        for (int j = 0; j < 4; ++j) acc[i][j] = 0.f;
    for (int k0 = 0; k0 < K; k0 += 16) {
#pragma unroll
        for (int i = 0; i < 4; ++i) { const int idx = tid + i * 256, r = idx >> 4, kk = idx & 15; As[kk][r] = A[(size_t)(m0 + r) * lda + k0 + kk]; }
#pragma unroll
        for (int i = 0; i < 4; ++i) { const int idx = tid + i * 256, kk = idx >> 6, c = idx & 63; Bs[kk][c] = (n0 + c < N) ? Bm[(size_t)(k0 + kk) * ldb + n0 + c] : 0.f; }
        __syncthreads();
#pragma unroll
        for (int kk = 0; kk < 16; ++kk) {
            float a[4], b[4];
#pragma unroll
            for (int i = 0; i < 4; ++i) a[i] = As[kk][ty * 4 + i];
#pragma unroll
            for (int j = 0; j < 4; ++j) b[j] = Bs[kk][tx * 4 + j];
#pragma unroll
            for (int i = 0; i < 4; ++i)
#pragma unroll
                for (int j = 0; j < 4; ++j) acc[i][j] = fmaf(a[i], b[j], acc[i][j]);
        }
        __syncthreads();
    }
#pragma unroll
    for (int i = 0; i < 4; ++i)
#pragma unroll
        for (int j = 0; j < 4; ++j) { const int r = m0 + ty * 4 + i, c = n0 + tx * 4 + j; if (c < N) C[(size_t)r * ldc + c] = acc[i][j] + (R ? R[(size_t)r * ldr + c] : 0.f); }
}

__global__ void fox_c(const float* proj, int ld, int off, const float* fb, float* c, int nb) {
    const int i = blockIdx.x * blockDim.x + threadIdx.x; if (i >= nb * 6) return;
    const int b = i / 6, h = i % 6; float acc = 0.f;
    for (int s = 0; s < S; ++s) { acc += logsig(proj[(size_t)(b * S + s) * ld + off + h] + fb[h]); c[(size_t)i * S + s] = acc; }
}

__global__ void rope(float* buf, int ld, int off, int nh, int hs, int rows) {
    const int i = blockIdx.x * blockDim.x + threadIdx.x; if (i >= rows * nh * 16) return;
    const int j = i & 15, h = (i >> 4) % nh, m = (i >> 4) / nh;
    const float inv = 1.0f / powf(10000.0f, (float)j / 16.0f);
    const float ang = (float)(m % S) * inv; const float cs = cosf(ang), sn = sinf(ang);
    float* p = buf + (size_t)m * ld + off + h * hs; const float x1 = p[j], x2 = p[16 + j];
    p[j] = x1 * cs - x2 * sn; p[16 + j] = x1 * sn + x2 * cs;
}
__global__ void copy_cols(const float* src, int lds_, int off, float* dst, int ldd, int width, int rows) {
    const int i = blockIdx.x * blockDim.x + threadIdx.x; if (i >= rows * width) return;
    const int m = i / width, c = i % width; dst[(size_t)m * ldd + c] = src[(size_t)m * lds_ + off + c];
}

template <int MODE, int DX>
__global__ void __launch_bounds__(64) attn(const float* Q, int ldq, int hsq, const float* K, int ldk, int hsk, const float* KX, int ldkx, int hskx,
                                           const float* V, int ldv, int hsv, float* O, int ldo, int hso, const float* cb, float scale) {
    constexpr int DQ = 64 + DX;
    __shared__ __attribute__((aligned(16))) float Ks[64][DQ];
    __shared__ __attribute__((aligned(16))) float Vs[64][64];
    __shared__ float cs[64];
    const int lane = threadIdx.x, qb = blockIdx.x, h = blockIdx.y, b = blockIdx.z, t = qb * 64 + lane;
    const size_t rowb = (size_t)b * S;
    float q[DQ], o[64];
#pragma unroll
    for (int d = 0; d < DQ; ++d) q[d] = Q[(rowb + t) * ldq + h * hsq + d] * scale;
#pragma unroll
    for (int d = 0; d < 64; ++d) o[d] = 0.f;
    const float ct = cb ? cb[((size_t)b * gridDim.y + h) * S + t] : 0.f;
    float mrun = -INFINITY, l = 0.f, R = 0.f;
    for (int it = 0; it <= qb; ++it) {
        const int kt = (MODE == 0) ? it : (qb - it);
        __syncthreads();
        for (int i = lane; i < 64 * 16; i += 64) { const int r = i >> 4, c4 = i & 15;
            *(float4*)&Ks[r][c4 * 4] = *(const float4*)&K[(rowb + kt * 64 + r) * ldk + h * hsk + c4 * 4];
            *(float4*)&Vs[r][c4 * 4] = *(const float4*)&V[(rowb + kt * 64 + r) * ldv + h * hsv + c4 * 4]; }
        if (DX > 0) for (int i = lane; i < 64 * (DX / 4); i += 64) { const int r = i / (DX / 4), c4 = i % (DX / 4);
            *(float4*)&Ks[r][64 + c4 * 4] = *(const float4*)&KX[(rowb + kt * 64 + r) * ldkx + h * hskx + c4 * 4]; }
        if (cb) cs[lane] = cb[((size_t)b * gridDim.y + h) * S + kt * 64 + lane];
        __syncthreads();
        for (int si = 0; si < 64; ++si) {
            const int sl = (MODE == 0) ? si : (63 - si); const int s = kt * 64 + sl;
            float dot = 0.f;
#pragma unroll
            for (int d = 0; d < DQ; d += 4) { const float4 kk = *(const float4*)&Ks[sl][d]; dot = fmaf(q[d], kk.x, dot); dot = fmaf(q[d + 1], kk.y, dot); dot = fmaf(q[d + 2], kk.z, dot); dot = fmaf(q[d + 3], kk.w, dot); }
            if (MODE == 0) {
                const bool valid = s <= t;
                const float logit = dot + (cb ? (ct - cs[sl]) : 0.f);
                if (valid) {
                    const float mn = fmaxf(mrun, logit), a = expf(mrun - mn), p = expf(logit - mn);
                    l = l * a + p; mrun = mn;
#pragma unroll
                    for (int d = 0; d < 64; d += 4) { const float4 vv = *(const float4*)&Vs[sl][d]; o[d] = o[d] * a + p * vv.x; o[d + 1] = o[d + 1] * a + p * vv.y; o[d + 2] = o[d + 2] * a + p * vv.z; o[d + 3] = o[d + 3] * a + p * vv.w; }
                }
            } else {
                const bool valid = s < t;
                if (valid) {
                    const float w = expf(logsig(dot) + R); R += logsig(-dot);
#pragma unroll
                    for (int d = 0; d < 64; d += 4) { const float4 vv = *(const float4*)&Vs[sl][d]; o[d] = fmaf(w, vv.x, o[d]); o[d + 1] = fmaf(w, vv.y, o[d + 1]); o[d + 2] = fmaf(w, vv.z, o[d + 2]); o[d + 3] = fmaf(w, vv.w, o[d + 3]); }
                }
            }
        }
    }
    const float inv = (MODE == 0) ? 1.0f / l : 1.0f;
#pragma unroll
    for (int d = 0; d < 64; ++d) O[(rowb + t) * ldo + h * hso + d] = o[d] * inv;
}

__global__ void __launch_bounds__(256) topk(const float* Q2, const float* keys1, const float* keys2, int* ids, float* gates) {
    const int gw = (blockIdx.x * 256 + threadIdx.x) >> 6, lane = threadIdx.x & 63;
    const int t = gw >> 3, h = gw & 7;
    const float* q = Q2 + (size_t)t * 2048 + h * 256;
    float s1a = 0.f, s1b = 0.f, s2a = 0.f, s2b = 0.f;
    for (int d = 0; d < 128; d += 4) {
        const float4 qa = *(const float4*)(q + d), qb = *(const float4*)(q + 128 + d);
        const float4 k1a = *(const float4*)(keys1 + lane * 128 + d), k1b = *(const float4*)(keys1 + (lane + 64) * 128 + d);
        const float4 k2a = *(const float4*)(keys2 + lane * 128 + d), k2b = *(const float4*)(keys2 + (lane + 64) * 128 + d);
        s1a += qa.x * k1a.x + qa.y * k1a.y + qa.z * k1a.z + qa.w * k1a.w; s1b += qa.x * k1b.x + qa.y * k1b.y + qa.z * k1b.z + qa.w * k1b.w;
        s2a += qb.x * k2a.x + qb.y * k2a.y + qb.z * k2a.z + qb.w * k2a.w; s2b += qb.x * k2b.x + qb.y * k2b.y + qb.z * k2b.z + qb.w * k2b.w;
    }
    float top1 = 0.f, top2 = 0.f; int idx1 = 0, idx2 = 0;
#pragma unroll
    for (int side = 0; side < 2; ++side) {
        float v0 = side ? s2a : s1a, v1 = side ? s2b : s1b; float tp = 0.f; int ti = 0;
        for (int k = 0; k < 16; ++k) {
            float bv; int bi; if (v0 >= v1) { bv = v0; bi = lane; } else { bv = v1; bi = lane + 64; }
#pragma unroll
            for (int o = 32; o >= 1; o >>= 1) { const float ov = __shfl_xor(bv, o); const int oi = __shfl_xor(bi, o); if (ov > bv || (ov == bv && oi < bi)) { bv = ov; bi = oi; } }
            if (lane == k) { tp = bv; ti = bi; }
            if (bi == lane) v0 = -INFINITY; if (bi == lane + 64) v1 = -INFINITY;
        }
        if (side) { top2 = tp; idx2 = ti; } else { top1 = tp; idx1 = ti; }
    }
    const float a = __shfl(top1, lane >> 2); const int ia = __shfl(idx1, lane >> 2);
    float c0, c1, c2, c3; int e0, e1, e2, e3;
    { const int jb = (lane & 3) * 4;
      c0 = a + __shfl(top2, jb + 0); e0 = ia * 128 + __shfl(idx2, jb + 0);
      c1 = a + __shfl(top2, jb + 1); e1 = ia * 128 + __shfl(idx2, jb + 1);
      c2 = a + __shfl(top2, jb + 2); e2 = ia * 128 + __shfl(idx2, jb + 2);
      c3 = a + __shfl(top2, jb + 3); e3 = ia * 128 + __shfl(idx2, jb + 3); }
    float best = 0.f; int bid = 0;
    for (int k = 0; k < 16; ++k) {
        float bv = c0; int bc = lane * 4, be = e0;
        if (c1 > bv) { bv = c1; bc = lane * 4 + 1; be = e1; }
        if (c2 > bv) { bv = c2; bc = lane * 4 + 2; be = e2; }
        if (c3 > bv) { bv = c3; bc = lane * 4 + 3; be = e3; }
#pragma unroll
        for (int o = 32; o >= 1; o >>= 1) { const float ov = __shfl_xor(bv, o); const int oc = __shfl_xor(bc, o), oe = __shfl_xor(be, o); if (ov > bv || (ov == bv && oc < bc)) { bv = ov; bc = oc; be = oe; } }
        if (lane == k) { best = bv; bid = be; }
        if (bc == lane * 4) c0 = -INFINITY; if (bc == lane * 4 + 1) c1 = -INFINITY; if (bc == lane * 4 + 2) c2 = -INFINITY; if (bc == lane * 4 + 3) c3 = -INFINITY;
    }
    const float mx = __shfl(best, 0);
    float e = (lane < 16) ? expf(best - mx) : 0.f;
    const float sum = wsum(e);
    if (lane < 16) { ids[(size_t)gw * 16 + lane] = bid; gates[(size_t)gw * 16 + lane] = e / sum; }
}

__global__ void __launch_bounds__(256) peer_gather(const float* H2, const float* X1, const int* ids, const float* gates, const float* U, const float* Vw, float* Xout) {
    const int t = (blockIdx.x * 256 + threadIdx.x) >> 6, lane = threadIdx.x & 63;
    float4 hv[4], acc[4];
#pragma unroll
    for (int j = 0; j < 4; ++j) { hv[j] = *(const float4*)(H2 + (size_t)t * D + j * 256 + lane * 4); acc[j] = make_float4(0.f, 0.f, 0.f, 0.f); }
    for (int e = 0; e < 128; ++e) {
        const int id = __builtin_amdgcn_readfirstlane(ids[(size_t)t * 128 + e]);
        const float gt = gates[(size_t)t * 128 + e];
        const float* ur = U + (size_t)id * D; const float* vr = Vw + (size_t)id * D;
        float p = 0.f;
#pragma unroll
        for (int j = 0; j < 4; ++j) { const float4 u4 = *(const float4*)(ur + j * 256 + lane * 4); p += hv[j].x * u4.x + hv[j].y * u4.y + hv[j].z * u4.z + hv[j].w * u4.w; }
        p = wsum(p);
        const float a = 0.5f * p * (1.0f + erff(p * 0.70710678118654752f)) * gt;
#pragma unroll
        for (int j = 0; j < 4; ++j) { const float4 v4 = *(const float4*)(vr + j * 256 + lane * 4); acc[j].x = fmaf(a, v4.x, acc[j].x); acc[j].y = fmaf(a, v4.y, acc[j].y); acc[j].z = fmaf(a, v4.z, acc[j].z); acc[j].w = fmaf(a, v4.w, acc[j].w); }
    }
#pragma unroll
    for (int j = 0; j < 4; ++j) { const float4 x4 = *(const float4*)(X1 + (size_t)t * D + j * 256 + lane * 4);
        *(float4*)(Xout + (size_t)t * D + j * 256 + lane * 4) = make_float4(x4.x + acc[j].x, x4.y + acc[j].y, x4.z + acc[j].z, x4.w + acc[j].w); }
}

struct Bufs { float *H, *PROJ, *Y, *X1, *Q2, *QUP, *KVUP, *CQN, *CKVN, *KR, *C, *GATES; int* IDS; };
static size_t carve(unsigned char* ws, size_t off, int rows, Bufs& b) {
    auto take = [&](size_t bytes) { unsigned char* p = ws + off; off += (bytes + 255) & ~(size_t)255; return p; };
    unsigned char* regionA = take((size_t)rows * INC * 4 + (size_t)rows * D * 4);
    b.PROJ = (float*)regionA; b.Y = (float*)(regionA + (size_t)rows * INC * 4); b.Q2 = (float*)regionA;
    b.H = (float*)take((size_t)rows * D * 4);
    b.QUP = (float*)take((size_t)rows * 384 * 4); b.KVUP = (float*)take((size_t)rows * 512 * 4); b.CQN = (float*)take((size_t)rows * 256 * 4); b.CKVN = (float*)take((size_t)rows * 128 * 4);
    b.KR = (float*)take((size_t)rows * 32 * 4); b.C = (float*)take((size_t)(rows / S) * 6 * S * 4); b.GATES = (float*)take((size_t)rows * 128 * 4); b.IDS = (int*)take((size_t)rows * 128 * 4);
    return off;
}
static void mixer(void* const* d_in, int l, const float* xin, const Bufs& b, int rows, int from, hipStream_t st) {
    const int nb = rows / S;
    const float* attn_g = (const float*)d_in[1] + (size_t)l * D; const float* w_in = (const float*)d_in[2] + (size_t)l * D * INC; const float* fb = (const float*)d_in[3] + l * 6;
    const float* qg = (const float*)d_in[4] + l * 256; const float* w_uq = (const float*)d_in[5] + (size_t)l * 256 * 384; const float* kvg = (const float*)d_in[6] + l * 128;
    const float* w_ukv = (const float*)d_in[7] + (size_t)l * 128 * 512; const float* g_fox = (const float*)d_in[8] + l * 384; const float* g_mla = (const float*)d_in[9] + l * 256;
    const float* g_sb = (const float*)d_in[10] + l * 384; const float* w_out = (const float*)d_in[11] + (size_t)l * D * D;
    if (from <= 0) {
        rmsnorm<<<rows / 4, 256, 0, st>>>(xin, D, attn_g, b.H, D, rows, D);
        gemm<<<dim3((INC + 63) / 64, rows / 64), 256, 0, st>>>(b.H, D, w_in, INC, b.PROJ, INC, nullptr, 0, rows, INC, D);
    }
    if (from <= 2) {
        fox_c<<<1, 64, 0, st>>>(b.PROJ, INC, 1152, fb, b.C, nb);
        attn<0, 0><<<dim3(S / 64, 6, nb), 64, 0, st>>>(b.PROJ, INC, 64, b.PROJ + 384, INC, 64, nullptr, 0, 0, b.PROJ + 768, INC, 64, b.Y, D, 64, b.C, 0.125f);
        if (from <= 1) {
            rmsnorm<<<rows / 4, 256, 0, st>>>(b.PROJ + 1158, INC, qg, b.CQN, 256, rows, 256);
            gemm<<<dim3(384 / 64, rows / 64), 256, 0, st>>>(b.CQN, 256, w_uq, 384, b.QUP, 384, nullptr, 0, rows, 384, 256);
            rope<<<(rows * 4 * 16 + 255) / 256, 256, 0, st>>>(b.QUP, 384, 64, 4, 96, rows);
            rmsnorm<<<rows / 4, 256, 0, st>>>(b.PROJ + 1414, INC, kvg, b.CKVN, 128, rows, 128);
            gemm<<<dim3(512 / 64, rows / 64), 256, 0, st>>>(b.CKVN, 128, w_ukv, 512, b.KVUP, 512, nullptr, 0, rows, 512, 128);
            copy_cols<<<(rows * 32 + 255) / 256, 256, 0, st>>>(b.PROJ, INC, 1542, b.KR, 32, 32, rows);
            rope<<<(rows * 16 + 255) / 256, 256, 0, st>>>(b.KR, 32, 0, 1, 0, rows);
        }
        attn<0, 32><<<dim3(S / 64, 4, nb), 64, 0, st>>>(b.QUP, 384, 96, b.KVUP, 512, 128, b.KR, 32, 0, b.KVUP + 64, 512, 128, b.Y + 384, D, 64, nullptr, 0.10206207261596577f);
        attn<1, 0><<<dim3(S / 64, 6, nb), 64, 0, st>>>(b.PROJ + 1574, INC, 64, b.PROJ + 1958, INC, 64, nullptr, 0, 0, b.PROJ + 2342, INC, 64, b.Y + 640, D, 64, nullptr, 0.125f);
    }
    rmsnorm<<<rows / 4, 256, 0, st>>>(b.Y, D, g_fox, b.Y, D, rows, 384);
    rmsnorm<<<rows / 4, 256, 0, st>>>(b.Y + 384, D, g_mla, b.Y + 384, D, rows, 256);
    rmsnorm<<<rows / 4, 256, 0, st>>>(b.Y + 640, D, g_sb, b.Y + 640, D, rows, 384);
    gemm<<<dim3(D / 64, rows / 64), 256, 0, st>>>(b.Y, D, w_out, D, b.X1, D, xin, D, rows, D, D);
}
static void peer(void* const* d_in, int l, const Bufs& b, float* xout, int rows, int from, const int* ids_in, const float* gates_in, hipStream_t st) {
    const float* ffn_g = (const float*)d_in[12] + (size_t)l * D; const float* wq = (const float*)d_in[13] + (size_t)l * D * 2048;
    const float* k1 = (const float*)d_in[14] + (size_t)l * 128 * 128; const float* k2 = (const float*)d_in[15] + (size_t)l * 128 * 128;
    const float* U = (const float*)d_in[16] + (size_t)l * 16384 * D; const float* Vw = (const float*)d_in[17] + (size_t)l * 16384 * D;
    rmsnorm<<<rows / 4, 256, 0, st>>>(b.X1, D, ffn_g, b.H, D, rows, D);
    const int* ids = b.IDS; const float* gates = b.GATES;
    if (from <= 0) {
        gemm<<<dim3(2048 / 64, rows / 64), 256, 0, st>>>(b.H, D, wq, 2048, b.Q2, 2048, nullptr, 0, rows, 2048, D);
        topk<<<rows * 8 / 4, 256, 0, st>>>(b.Q2, k1, k2, b.IDS, b.GATES);
    } else { ids = ids_in; gates = gates_in; }
    peer_gather<<<rows / 4, 256, 0, st>>>(b.H, b.X1, ids, gates, U, Vw, xout);
}
static void forward(void* const* d_in, float* d_out, unsigned char* ws, size_t off, hipStream_t st) {
    Bufs b; off = carve(ws, off, M, b); b.X1 = d_out; float* X2 = (float*)(ws + off);
    const float* x = (const float*)d_in[0];
    mixer(d_in, 0, x, b, M, 0, st); peer(d_in, 0, b, X2, M, 0, nullptr, nullptr, st);
    mixer(d_in, 1, X2, b, M, 0, st); peer(d_in, 1, b, X2, M, 0, nullptr, nullptr, st);
    rmsnorm<<<M / 4, 256, 0, st>>>(X2, D, (const float*)d_in[18], d_out, D, M, D);
}
}

namespace pg8 {

#define PG8_LAS __attribute__((address_space(3)))
typedef unsigned short bf16_t;
typedef short bf16x8 __attribute__((ext_vector_type(8)));
typedef float f32x4 __attribute__((ext_vector_type(4)));
typedef unsigned u32x4 __attribute__((ext_vector_type(4)));
constexpr int BM = 256, BK = 64, HALF = 128, HTB = HALF * BK * 2  , STAGE_BYTES = 8 * HTB, NXCD = 8, WGM = 8;

__host__ __device__ __forceinline__ int lds_byte(int r, int c) { const int st = (r >> 4) * 2 + (c >> 5), rr = r & 15, cc = c & 31, ob = rr * 64 + cc * 2; return st * 1024 + (ob ^ (((ob >> 9) & 1) << 5)); }
__host__ __device__ __forceinline__ void stage_rc(int b, int& R, int& C) { const int st = b / 1024, sb = b % 1024, swz = sb ^ (((sb >> 9) & 1) << 5); R = (st >> 1) * 16 + swz / 64; C = (st & 1) * 32 + (swz % 64) / 2; }
__host__ __device__ __forceinline__ int perm32(int rho) { const int n = rho >> 4, i = rho & 15; return 8 * (i >> 2) + 4 * n + (i & 3); }

struct Unit { int pm, pn; };
struct Gemm { const bf16_t* A; const bf16_t* Bt; int M, N, K, lda, ldb; };

struct StaticOrder {
    int nM, nN, nwg, G, c;
    __host__ __device__ __forceinline__ void init(int M, int N, int G_, int c_) { nM = M / BM; nN = N / BM; nwg = nM * nN; G = G_; c = c_; }
    __host__ __device__ __forceinline__ bool next(int i, Unit& u) const {
        const long L = (long)i * G + c; if (L >= nwg) return false;
        int wgid = (int)L; { const int q = nwg / NXCD, r = nwg % NXCD, xcd = wgid % NXCD, off = wgid / NXCD; wgid = (xcd < r ? xcd * (q + 1) : r * (q + 1) + (xcd - r) * q) + off; }
        const int nig = WGM * nN, gid = wgid / nig, fm = gid * WGM, gsz = (nM - fm) < WGM ? (nM - fm) : WGM;
        u.pm = fm + ((wgid % nig) % gsz); u.pn = (wgid % nig) / gsz; return true;
    }
    __device__ __forceinline__ void a_ready(const Unit&) const {}
    __device__ __forceinline__ void done(const Unit&) const {}
};

template <class Epi, class Sched, bool ALIGN_EPI = false, bool SP2 = false>
__device__ __forceinline__ void gemm_phase(PG8_LAS unsigned char* lds, const Gemm g, const Sched& S, const Epi& E) {
    int tid_ = threadIdx.x; asm volatile("" : "+v"(tid_));
    const int tid = tid_, wid = __builtin_amdgcn_readfirstlane(tid >> 6), lane = tid & 63, wr = wid >> 2, wc = wid & 3, fr = lane & 15, fq = lane >> 4;
    const int K = g.K, nt = K / BK;
    unsigned voffA[2], voffB[2];
#pragma unroll
    for (int i = 0; i < 2; ++i) { int R, C; stage_rc(tid * 16 + i * 8192, R, C); const int Rb = Epi::PERM ? ((R & ~31) + perm32(R & 31)) : R;
        voffA[i] = (unsigned)(R * g.lda + C) * 2u; voffB[i] = (unsigned)(Rb * g.ldb + C) * 2u; }
    const size_t kstep = (size_t)(BK * 2);
    const size_t hstepA = (size_t)HALF * g.lda * 2, hstepB = (size_t)HALF * g.ldb * 2;
    const size_t tstepA = 2 * hstepA, tstepB = 2 * hstepB;
    const unsigned ldsw = (unsigned)wid * 1024u;
    const int aoff = lds_byte(wr * 64 + fr, fq * 8), boff = lds_byte(wc * 32 + fr, fq * 8);
#define PG8_SA(b, h) (((b) * 2 + (h)) * HTB)
#define PG8_SB(b, h) ((4 + (b) * 2 + (h)) * HTB)
#define PG8_STAGE(bufoff, gbase, voff) do { _Pragma("unroll") for (int _i = 0; _i < 2; ++_i) \
        __builtin_amdgcn_global_load_lds((const unsigned*)((const char*)(gbase) + (voff)[_i]), (PG8_LAS unsigned*)(lds + (bufoff) + ldsw + _i * 8192), 16, 0, 0); } while (0)
#define PG8_LDA(dst, b, h) do { _Pragma("unroll") for (int m = 0; m < 4; ++m) _Pragma("unroll") for (int k = 0; k < 2; ++k) dst[m][k] = *(const PG8_LAS bf16x8*)(lds + PG8_SA(b, h) + aoff + m * 2048 + k * 1024); } while (0)
#define PG8_LDB(dst, b, h) do { _Pragma("unroll") for (int n = 0; n < 2; ++n) _Pragma("unroll") for (int k = 0; k < 2; ++k) dst[n][k] = *(const PG8_LAS bf16x8*)(lds + PG8_SB(b, h) + boff + n * 2048 + k * 1024); } while (0)
#define PG8_MMA(ai, bj, At, Bt) do { __builtin_amdgcn_s_setprio(1); _Pragma("unroll") for (int m = 0; m < 4; ++m) _Pragma("unroll") for (int n = 0; n < 2; ++n) _Pragma("unroll") for (int k = 0; k < 2; ++k) \
        acc[ai][bj][m][n] = __builtin_amdgcn_mfma_f32_16x16x32_bf16(Bt[n][k], At[m][k], acc[ai][bj][m][n], 0, 0, 0); __builtin_amdgcn_s_setprio(0); } while (0)
#define PG8_WAIT_V(n) asm volatile("s_waitcnt vmcnt(" #n ")" ::: "memory")
#define PG8_WAIT_L(n) asm volatile("s_waitcnt lgkmcnt(" #n ")" ::: "memory")
#define PG8_BAR __builtin_amdgcn_s_barrier()
#define PG8_SCHED __builtin_amdgcn_sched_barrier(0)
    Unit cur, nxt; int ui = 0;
    if (!S.next(0, cur)) return;
    f32x4 acc[2][2][4][2];
    float zf_ = 0.f; asm volatile("" : "+v"(zf_));
#pragma unroll
    for (int a = 0; a < 2; ++a)
#pragma unroll
        for (int b = 0; b < 2; ++b)
#pragma unroll
            for (int m = 0; m < 4; ++m)
#pragma unroll
                for (int n = 0; n < 2; ++n) acc[a][b][m][n] = (f32x4){zf_, zf_, zf_, zf_};
    bf16x8 At[4][2], B0[2][2], B1[2][2];
    const char* cA = (const char*)g.A + (size_t)cur.pm * tstepA; const char* cB = (const char*)g.Bt + (size_t)cur.pn * tstepB;
    S.a_ready(cur);
    if constexpr (SP2) {
        PG8_STAGE(PG8_SB(0, 0), cB, voffB); PG8_STAGE(PG8_SB(0, 1), cB + hstepB, voffB); PG8_STAGE(PG8_SA(0, 0), cA, voffA); PG8_STAGE(PG8_SA(0, 1), cA + hstepA, voffA);
        if (wr == 1) PG8_BAR;
        PG8_WAIT_V(2); PG8_BAR;
        PG8_STAGE(PG8_SB(1, 0), cB + kstep, voffB); PG8_STAGE(PG8_SA(1, 0), cA + kstep, voffA); PG8_STAGE(PG8_SB(1, 1), cB + hstepB + kstep, voffB);
        PG8_WAIT_V(6); PG8_BAR;
    } else {
        PG8_STAGE(PG8_SB(0, 0), cB, voffB); PG8_STAGE(PG8_SA(0, 0), cA, voffA); PG8_STAGE(PG8_SB(0, 1), cB + hstepB, voffB); PG8_STAGE(PG8_SA(0, 1), cA + hstepA, voffA);
        if (wr == 1) PG8_BAR;
        PG8_WAIT_V(4); PG8_BAR;
        PG8_STAGE(PG8_SB(1, 0), cB + kstep, voffB); PG8_STAGE(PG8_SA(1, 0), cA + kstep, voffA); PG8_STAGE(PG8_SB(1, 1), cB + hstepB + kstep, voffB);
        PG8_WAIT_V(6); PG8_BAR;
    }
    for (;;) {
        const bool has_next = S.next(ui + 1, nxt);
        const char* nA = has_next ? (const char*)g.A + (size_t)nxt.pm * tstepA : cA; const char* nB = has_next ? (const char*)g.Bt + (size_t)nxt.pn * tstepB : cB;
#pragma unroll 1
        for (int t = 0; t < nt; t += 2) {
            const bool last = (t == nt - 2);
            const char* a1 = cA + (size_t)(t + 1) * kstep;
            const char* a2 = last ? nA : cA + (size_t)(t + 2) * kstep; const char* b2 = last ? nB : cB + (size_t)(t + 2) * kstep;
            const char* a3 = a2 + kstep; const char* b3 = b2 + kstep;
            if (last && has_next) S.a_ready(nxt);
            if constexpr (Epi::HAS_MID) { if (t == Epi::MID0 || t == Epi::MID1) E.mid(acc, t, wr, fr); }
            if constexpr (SP2) {
            PG8_LDB(B0, 0, 0); PG8_LDB(B1, 0, 1); PG8_SCHED; PG8_LDA(At, 0, 0); PG8_STAGE(PG8_SA(1, 1), a1 + hstepA, voffA);
            PG8_WAIT_V(8); PG8_WAIT_L(0); PG8_BAR; PG8_MMA(0, 0, At, B0); PG8_MMA(0, 1, At, B1); PG8_BAR; PG8_SCHED;
            PG8_LDA(At, 0, 1); PG8_STAGE(PG8_SB(0, 0), b2, voffB); PG8_STAGE(PG8_SB(0, 1), b2 + hstepB, voffB); PG8_STAGE(PG8_SA(0, 0), a2, voffA);
            PG8_WAIT_V(8); PG8_WAIT_L(0); PG8_BAR; PG8_MMA(1, 0, At, B0); PG8_MMA(1, 1, At, B1); PG8_BAR; PG8_SCHED;
            PG8_LDB(B0, 1, 0); PG8_LDB(B1, 1, 1); PG8_SCHED; PG8_LDA(At, 1, 0); PG8_STAGE(PG8_SA(0, 1), a2 + hstepA, voffA);
            PG8_WAIT_V(8); PG8_WAIT_L(0); PG8_BAR; PG8_MMA(0, 0, At, B0); PG8_MMA(0, 1, At, B1); PG8_BAR; PG8_SCHED;
            PG8_LDA(At, 1, 1); PG8_STAGE(PG8_SB(1, 0), b3, voffB); PG8_STAGE(PG8_SB(1, 1), b3 + hstepB, voffB); PG8_STAGE(PG8_SA(1, 0), a3, voffA);
            PG8_WAIT_V(8); PG8_WAIT_L(0); PG8_BAR; PG8_MMA(1, 0, At, B0); PG8_MMA(1, 1, At, B1); PG8_BAR; PG8_SCHED;
            } else {
            PG8_LDB(B0, 0, 0); PG8_SCHED; PG8_LDA(At, 0, 0); PG8_STAGE(PG8_SA(1, 1), a1 + hstepA, voffA);
            PG8_WAIT_L(8); PG8_BAR; PG8_WAIT_L(0); PG8_MMA(0, 0, At, B0); PG8_BAR; PG8_SCHED;
            PG8_LDB(B1, 0, 1); PG8_STAGE(PG8_SB(0, 0), b2, voffB);
            PG8_BAR; PG8_WAIT_L(0); PG8_MMA(0, 1, At, B1); PG8_BAR;
            PG8_LDA(At, 0, 1); PG8_STAGE(PG8_SA(0, 0), a2, voffA);
            PG8_BAR; PG8_WAIT_L(0); PG8_MMA(1, 0, At, B0); PG8_BAR; PG8_SCHED;
            PG8_STAGE(PG8_SB(0, 1), b2 + hstepB, voffB);
            PG8_WAIT_V(6); PG8_BAR; PG8_MMA(1, 1, At, B1); PG8_BAR;
            PG8_LDB(B0, 1, 0); PG8_SCHED; PG8_LDA(At, 1, 0); PG8_STAGE(PG8_SA(0, 1), a2 + hstepA, voffA);
            PG8_WAIT_L(8); PG8_BAR; PG8_WAIT_L(0); PG8_MMA(0, 0, At, B0); PG8_BAR; PG8_SCHED;
            PG8_LDB(B1, 1, 1); PG8_STAGE(PG8_SB(1, 0), b3, voffB);
            PG8_BAR; PG8_WAIT_L(0); PG8_MMA(0, 1, At, B1); PG8_BAR;
            PG8_LDA(At, 1, 1); PG8_STAGE(PG8_SA(1, 0), a3, voffA);
            PG8_BAR; PG8_WAIT_L(0); PG8_MMA(1, 0, At, B0); PG8_BAR; PG8_SCHED;
            PG8_STAGE(PG8_SB(1, 1), b3 + hstepB, voffB);
            PG8_WAIT_V(6); PG8_BAR; PG8_MMA(1, 1, At, B1); PG8_BAR;
            }
        }
        if constexpr (ALIGN_EPI) { if (wr == 0) PG8_BAR; }
        if constexpr (!Epi::AFTER_DRAIN) { E(acc, cur, wr, wc, fr, fq); S.done(cur); }
        if (!has_next) break;
#pragma unroll
        for (int a = 0; a < 2; ++a)
#pragma unroll
            for (int b = 0; b < 2; ++b)
#pragma unroll
                for (int m = 0; m < 4; ++m)
#pragma unroll
                    for (int n = 0; n < 2; ++n) acc[a][b][m][n] = (f32x4){zf_, zf_, zf_, zf_};
        cur = nxt; cA = nA; cB = nB; ++ui;
        if constexpr (ALIGN_EPI) { if (wr == 1) PG8_BAR; }
    }
    PG8_WAIT_V(0);
    if constexpr (!ALIGN_EPI) { if (wr == 0) PG8_BAR; }
    PG8_BAR;
    if constexpr (Epi::AFTER_DRAIN) { E.fused(acc, cur, wr, wc, fr, fq, lds, wid, lane); S.done(cur); }
#undef PG8_SA
#undef PG8_SB
#undef PG8_STAGE
#undef PG8_LDA
#undef PG8_LDB
#undef PG8_MMA
#undef PG8_WAIT_V
#undef PG8_WAIT_L
#undef PG8_BAR
#undef PG8_SCHED
}
}

#ifndef MK_UEXP
#define MK_UEXP 0
#ifndef MK_CONVQ
#define MK_CONVQ 1
#endif
#endif
namespace fx {
using pg8::bf16_t; using pg8::f32x4; using pg8::u32x4; using pg8::bf16x8;
typedef unsigned u32x2 __attribute__((ext_vector_type(2)));
typedef float f32x2 __attribute__((ext_vector_type(2)));
constexpr int B = 8, S = 2048, D = 1024, M = B * S, INC = 2726, NP = 2816;
constexpr float EPS = 1e-6f, LOG2E = 1.4426950408889634f;
constexpr float C2 = 0.125f * LOG2E;
constexpr float C2M = 0.10206207261596577f * LOG2E;
constexpr int PC_FQ = 0, PC_FK = 384, PC_FV = 768, PC_SQ = 1152, PC_SK = 1536, PC_SV = 1920, PC_CQ = 2304, PC_CKV = 2560, PC_KR = 2688, PC_FL = 2720;
constexpr int NWAVES = 8;
constexpr size_t MiB = 1u << 20;
constexpr size_t WS_CTL = 0, CTL_ZERO_BYTES = 1 * MiB;
constexpr size_t WS_WIN = 1 * MiB, WIN_L = (size_t)NP * D * 2;
constexpr size_t WS_WMLA = 12 * MiB, WMLA_L = (size_t)1024 * 384 * 2;
constexpr size_t WS_WOUT = 14 * MiB, WOUT_L = (size_t)D * D * 2;
constexpr size_t WS_WQ = 18 * MiB, WQ_L = (size_t)2048 * D * 2;
constexpr size_t WS_KEYS = 26 * MiB;
constexpr size_t WS_ROPE = 26 * MiB + 512 * 1024;
constexpr size_t WS_UB = 27 * MiB, UB_L = (size_t)16384 * D;
constexpr size_t WS_VB = 91 * MiB;
constexpr size_t WS_XN = 155 * MiB;
constexpr size_t WS_PROJ = 187 * MiB;
constexpr size_t WS_QUP = 275 * MiB, WS_KVUP = 287 * MiB, WS_KR = 303 * MiB, WS_KEXT = 304 * MiB;
constexpr size_t WS_FLOG = 307 * MiB, WS_SSQQ = 307 * MiB + 512 * 1024, WS_SSQKV = 307 * MiB + 768 * 1024;
constexpr size_t WS_Y = 308 * MiB;
constexpr size_t WS_PART = WS_PROJ;
constexpr size_t WS_QF = WS_PROJ;
constexpr size_t WS_SSQH = 340 * MiB, WS_SSQX = 341 * MiB, WS_X1B = 342 * MiB, WS_X2 = 374 * MiB, WS_IDS = 438 * MiB, WS_GATES = 446 * MiB, WS_SSQ2 = 454 * MiB  , WS_RSX = 454 * MiB + 512 * 1024  , WS_XQ = 455 * MiB  , WS_AVB = 471 * MiB  , WS_AH = 475 * MiB, WS_AL = 477 * MiB  , WS_END = 479 * MiB;
static_assert(WS_QF + (size_t)M * 2048 * 4 <= WS_SSQH, "Q overlay");
constexpr int CW_BAR = 4096, CW_ATTQ = 16384;
constexpr int RING_BYTES = 131072, LDSCTL_OFF = RING_BYTES, MISC_OFF = LDSCTL_OFF + 320, FAC_OFF = RING_BYTES + 1024, LDS_BYTES = 147456;
static_assert(FAC_OFF + 3 * 256 * 4 <= LDS_BYTES, "lds map");

#define GAS __attribute__((address_space(1)))
#define LAS __attribute__((address_space(3)))
typedef unsigned v4u __attribute__((ext_vector_type(4)));
typedef GAS unsigned gu32;
#define RLX_AGENT __ATOMIC_RELAXED, __HIP_MEMORY_SCOPE_AGENT
#define LDS_WAIT() asm volatile("s_waitcnt lgkmcnt(0)" ::: "memory")
#define VM_WAIT() asm volatile("s_waitcnt vmcnt(0)" ::: "memory")
__device__ __forceinline__ unsigned f2bf(float f) { unsigned u = __builtin_bit_cast(unsigned, f); return (u + 0x7fffu + ((u >> 16) & 1u)) >> 16; }
__device__ __forceinline__ unsigned pk2(float lo, float hi) { return f2bf(lo) | (f2bf(hi) << 16); }
__device__ __forceinline__ float bf2f(unsigned short b) { return __builtin_bit_cast(float, (unsigned)b << 16); }
__device__ __forceinline__ unsigned cvt_pk(float lo, float hi) { typedef float f2 __attribute__((ext_vector_type(2))); typedef __bf16 b2 __attribute__((ext_vector_type(2))); f2 v = {lo, hi}; b2 b = __builtin_convertvector(v, b2); return __builtin_bit_cast(unsigned, b); }
__device__ __forceinline__ float wave_sum(float v) {
#pragma unroll
    for (int o = 1; o < 64; o <<= 1) v += __shfl_xor(v, o);
    return v;
}

#define XB_TMO      128
#define XB_XCNT(j)  (256  + 64 * (j))
#define XB_XSUB(j)  (1280 + 64 * (j))
#define XB_XGEN(j)  (2304 + 64 * (j))
#define XB_TOP      3328
#define XB_TOPGEN   3392
#define XCD_BAR_WORDS 3456
#define XB_SPIN_CAP (1u << 20)
__device__ __forceinline__ unsigned xb_ld(unsigned* p)              { return __hip_atomic_load(p, __ATOMIC_RELAXED, __HIP_MEMORY_SCOPE_AGENT); }
__device__ __forceinline__ unsigned xb_add(unsigned* p, unsigned v) { return __hip_atomic_fetch_add(p, v, __ATOMIC_RELAXED, __HIP_MEMORY_SCOPE_AGENT); }
__device__ __forceinline__ unsigned xb_xcc_id() { return (unsigned)__builtin_amdgcn_s_getreg((3 << 11) | 20) & 0xFu; }
#define XB_SPIN(cond, bar) do { unsigned _sp = 0; while (cond) { __builtin_amdgcn_s_sleep(1); \
    if ((++_sp & 255u) == 0u) { if (xb_ld(&(bar)[XB_TMO])) break; if (_sp > XB_SPIN_CAP) { atomicAdd(&(bar)[XB_TMO], 1u); break; } } } } while (0)
struct XcdBarrier { unsigned* bar; unsigned x; volatile LAS unsigned* st; };
__device__ __forceinline__ XcdBarrier xcd_barrier_post(unsigned* bar, volatile LAS unsigned* st) {
    XcdBarrier b; b.bar = bar; b.x = xb_xcc_id(); b.st = st;
    if (threadIdx.x == 0) (void)xb_add(&bar[XB_XCNT(b.x)], 1u);
    return b;
}
__device__ __forceinline__ void xcd_barrier_complete(unsigned* bar, unsigned x, unsigned& nloc, unsigned& nx) {
    const unsigned G = gridDim.x * gridDim.y * gridDim.z;
    unsigned sum, cnt, mine, sp = 0u;
    for (;;) {
        sum = 0u; cnt = 0u; mine = 0u;
#pragma unroll
        for (unsigned j = 0; j < 16; ++j) { const unsigned c = xb_ld(&bar[XB_XCNT(j)]); sum += c; cnt += (c > 0u) ? 1u : 0u; mine = (j == x) ? c : mine; }
        if (sum == G) break;
        __builtin_amdgcn_s_sleep(1);
        if ((++sp & 255u) == 0u) { if (xb_ld(&bar[XB_TMO])) break; if (sp > XB_SPIN_CAP) { atomicAdd(&bar[XB_TMO], 1u); break; } }
    }
    nloc = mine > 0u ? mine : 1u; nx = cnt > 0u ? cnt : 1u;
}
__device__ __forceinline__ void xcd_barrier(const XcdBarrier& b) {
    asm volatile("s_waitcnt vmcnt(0)" ::: "memory");
    __syncthreads();
    if (threadIdx.x == 0) {
        unsigned* bar = b.bar;
        __builtin_amdgcn_s_waitcnt(0);
        unsigned nloc = b.st[0], nx = b.st[1];
        if (nloc == 0u) { xcd_barrier_complete(bar, b.x, nloc, nx); b.st[0] = nloc; b.st[1] = nx; }
        const unsigned old = xb_add(&bar[XB_XSUB(b.x)], 1u);
        const unsigned gen = old / nloc;
        if (old + 1u == (gen + 1u) * nloc) {
            __builtin_amdgcn_fence(__ATOMIC_RELEASE, "agent");
            asm volatile("s_waitcnt vmcnt(0)" ::: "memory");
            const unsigned og = xb_add(&bar[XB_TOP], 1u);
            const unsigned tg = og / nx;
            if (og + 1u == (tg + 1u) * nx) xb_add(&bar[XB_TOPGEN], 1u);
            else XB_SPIN(xb_ld(&bar[XB_TOPGEN]) == tg, bar);
            __builtin_amdgcn_fence(__ATOMIC_ACQUIRE, "agent");
            xb_add(&bar[XB_XGEN(b.x)], 1u);
            asm volatile("s_waitcnt vmcnt(0)" ::: "memory");
        } else {
            XB_SPIN(xb_ld(&bar[XB_XGEN(b.x)]) == gen, bar);
            __builtin_amdgcn_fence(__ATOMIC_ACQUIRE, "agent");
            asm volatile("s_waitcnt vmcnt(0)" ::: "memory");
        }
    }
    __syncthreads();
}

struct Args { const float* in[19]; float* out; unsigned char* ws; int ph_lo, ph_hi, li, pad; };
struct Frame {
    LAS unsigned char* lds; volatile LAS unsigned* MISC; gu32* ctl;
    int tid, lane, wave, vcu, G;
    const __attribute__((address_space(4))) Args* a;
    unsigned char* ws;
};
template <class T> __device__ __forceinline__ T* wsp(const Frame& F, size_t off) { return (T*)(F.ws + off); }

template <class Src> __device__ __forceinline__ void tr_item(const Src& src, bf16_t* WT, int ldt, int nblk, LAS float* scr, int item, int lane) {
    const int kb = item / nblk, nb = item % nblk, k0 = 64 * kb, n0 = 32 * nb;
#pragma unroll 8
    for (int i = 0; i < 32; ++i) { const int kk = 2 * i + (lane >> 5); scr[kk * 33 + (lane & 31)] = src(k0 + kk, n0 + (lane & 31)); }
    LDS_WAIT(); asm volatile("" ::: "memory");
    const int c = lane & 7;
#pragma unroll
    for (int j = 0; j < 4; ++j) { const int n = (lane >> 3) + 8 * j; const LAS float* s = scr + (8 * c) * 33 + n;
        v4u o; o.x = pk2(s[0 * 33], s[1 * 33]); o.y = pk2(s[2 * 33], s[3 * 33]); o.z = pk2(s[4 * 33], s[5 * 33]); o.w = pk2(s[6 * 33], s[7 * 33]);
        *(GAS v4u*)(WT + (size_t)(n0 + n) * ldt + k0 + 8 * c) = o; }
    LDS_WAIT(); asm volatile("" ::: "memory");
}
__device__ __forceinline__ int win_srccol(int n) {
    if (n < 1152) return n; if (n < 2304) return n - 1152 + 1574; if (n < 2560) return n - 2304 + 1158; if (n < 2688) return n - 2560 + 1414;
    if (n < 2720) return n - 2688 + 1542; if (n < 2726) return n - 2720 + 1152; return -1;
}
__device__ __forceinline__ void xn_row(const float* xrow, bf16_t* orow, float* ssq2, int lane) {
    const GAS f32x4* xr = (const GAS f32x4*)xrow + lane;
    f32x4 v[4]; float s = 0.f;
#pragma unroll
    for (int j = 0; j < 4; ++j) { v[j] = xr[64 * j]; s += (v[j].x * v[j].x + v[j].y * v[j].y) + (v[j].z * v[j].z + v[j].w * v[j].w); }
    s = wave_sum(s);
    if (lane < 8) ssq2[lane] = (lane == 0) ? s : 0.f;
    GAS unsigned long long* o8 = (GAS unsigned long long*)orow + lane;
#pragma unroll
    for (int j = 0; j < 4; ++j) o8[64 * j] = (unsigned long long)pk2(v[j].x, v[j].y) | ((unsigned long long)pk2(v[j].z, v[j].w) << 32);
}
__device__ __forceinline__ void p0_prologue(Frame& F, int parts) {
    LAS float* scr = (LAS float*)(F.lds + F.wave * 16384);
    const int gw = F.vcu * NWAVES + F.wave, NGW = F.G * NWAVES, lane = F.lane;
    const __attribute__((address_space(4))) Args* A = F.a;
    if (parts & 1) {
        constexpr int I_IN = (D / 64) * (NP / 32), I_MLA = (384 / 64) * (1024 / 32), I_OUT = (D / 64) * (D / 32), I_Q = (D / 64) * (2048 / 32);
        constexpr int PER_L = I_IN + I_MLA + I_OUT + I_Q;
        for (int it = gw; it < 2 * PER_L; it += NGW) {
            const int l = it / PER_L; int r = it % PER_L;
            if (r < I_IN) { const float* w = A->in[2] + (size_t)l * D * INC; const float* g = A->in[1] + l * D;
                tr_item([&](int k, int n) { const int sc = win_srccol(n); return sc >= 0 ? w[(size_t)k * INC + sc] * g[k] : 0.f; }, wsp<bf16_t>(F, WS_WIN + l * WIN_L), D, NP / 32, scr, r, lane); continue; }
            r -= I_IN;
            if (r < I_MLA) { const float* wq = A->in[5] + (size_t)l * 256 * 384; const float* qg = A->in[4] + l * 256; const float* wkv = A->in[7] + (size_t)l * 128 * 512; const float* kvg = A->in[6] + l * 128;
                tr_item([&](int k, int n) { float v = 0.f; if (n < 384) { if (k < 256) v = wq[k * 384 + n] * qg[k]; } else if (n < 896) { if (k >= 256) v = wkv[(k - 256) * 512 + (n - 384)] * kvg[k - 256]; } return v; },
                        wsp<bf16_t>(F, WS_WMLA + l * WMLA_L), 384, 1024 / 32, scr, r, lane); continue; }
            r -= I_MLA;
            if (r < I_OUT) { const float* w = A->in[11] + (size_t)l * D * D; const float* g1 = A->in[8] + l * 384; const float* g2 = A->in[9] + l * 256; const float* g3 = A->in[10] + l * 384;
                tr_item([&](int k, int n) { const float g = k < 384 ? g1[k] : (k < 640 ? g2[k - 384] : g3[k - 640]); return w[(size_t)k * D + n] * g; }, wsp<bf16_t>(F, WS_WOUT + l * WOUT_L), D, D / 32, scr, r, lane); continue; }
            r -= I_OUT;
            { const float* w = A->in[13] + (size_t)l * D * 2048; const float* g = A->in[12] + l * D;
              tr_item([&](int k, int n) { return w[(size_t)k * 2048 + n] * g[k]; }, wsp<bf16_t>(F, WS_WQ + l * WQ_L), D, 2048 / 32, scr, r, lane); }
        }
        float* ct = wsp<float>(F, WS_ROPE); float* stb = ct + 2048 * 16;
        { bf16_t* kb = wsp<bf16_t>(F, WS_KEYS);
          for (int i = gw * 64 + lane; i < 2 * 65536; i += NGW * 64) { const int l = i >> 16, row = (i >> 8) & 255, d = i & 255, b = row >> 5, rho = row & 31, side = (rho >> 2) & 1, key = 16 * b + 4 * (rho >> 3) + (rho & 3);
              const int ks = d >> 4, hi = (d >> 3) & 1, jj = d & 7;
              kb[(size_t)l * 65536 + (size_t)(((b * 16 + ks) * 64 + hi * 32 + rho) * 8 + jj)] = ((d >> 7) == side) ? (bf16_t)f2bf(A->in[14 + side][(size_t)l * 16384 + key * 128 + (d & 127)]) : (bf16_t)0; } }
        for (int i = gw * 64 + lane; i < 2048 * 16; i += NGW * 64) { const int pos = i >> 4, j = i & 15; const float inv = 1.0f / powf(10000.0f, (float)j / 16.0f); const float ang = (float)pos * inv; ct[i] = cosf(ang); stb[i] = sinf(ang); }
    }
    if ((parts & 2) && !MK_CONVQ) {
        const size_t n16 = (size_t)2 * 16384 * D / 16;
        for (int t = 0; t < 2; ++t) {
            const GAS f32x4* src = (const GAS f32x4*)A->in[16 + t]; GAS v4u* dst = (GAS v4u*)(F.ws + (t ? WS_VB : WS_UB)); const float sc = t ? 8.0f : 64.0f;
            for (size_t i = (size_t)gw * 64 + lane; i < n16; i += (size_t)NGW * 64) { v4u o;
#pragma unroll
                for (int j = 0; j < 4; ++j) { const f32x4 x = src[4 * i + j] * sc; int w = __builtin_amdgcn_cvt_pk_fp8_f32(x[0], x[1], 0, false); w = __builtin_amdgcn_cvt_pk_fp8_f32(x[2], x[3], w, true); o[j] = (unsigned)w; }
                if (MK_UEXP && t == 0) dst[i] = o;
                else { const size_t rr = i >> 6, g16 = i & 63, l2 = rr >> 14, r = rr & 16383; dst[((l2 * 8 + (g16 >> 3)) * 16384 + r) * 8 + (g16 & 7)] = o; } }
        }
    }
    if (parts & 4) { const float* xsrc = (parts & 8) ? wsp<float>(F, WS_X2) : A->in[0]; for (int m = gw; m < M; m += NGW) xn_row(xsrc + (size_t)m * D, wsp<bf16_t>(F, WS_XN) + (size_t)m * D, wsp<float>(F, WS_SSQ2) + (size_t)m * 8, lane); }
}

struct EpiG1 {
    static constexpr bool PERM = true, AFTER_DRAIN = false, HAS_MID = false; static constexpr int MID0 = -1, MID1 = -1;
    bf16_t* P; float* flog; float* ssqq; float* ssqkv; const float* ssq2;
    __device__ __forceinline__ void mid(f32x4 (&)[2][2][4][2], int, int, int) const {}
    __device__ __forceinline__ void operator()(const f32x4 (&acc)[2][2][4][2], const pg8::Unit& u, int wr, int wc, int fr, int fq) const {
        const int row0 = u.pm * 256 + wr * 64 + fr, col0 = u.pn * 256 + wc * 32 + 8 * fq;
        const bool want_sq = (u.pn == 9 || u.pn == 10);
        float rsxv[8];
#pragma unroll
        for (int it = 0; it < 8; ++it) { const int row = row0 + (it >> 2) * 128 + (it & 3) * 16;
            const f32x4 qa_ = *(const GAS f32x4*)(ssq2 + (size_t)row * 8), qb_ = *(const GAS f32x4*)(ssq2 + (size_t)row * 8 + 4);
            rsxv[it] = 1.0f / sqrtf((((qa_[0] + qa_[1]) + (qa_[2] + qa_[3])) + ((qb_[0] + qb_[1]) + (qb_[2] + qb_[3]))) * (1.f / D) + EPS); }
#pragma unroll
        for (int ai = 0; ai < 2; ++ai)
#pragma unroll
            for (int m = 0; m < 4; ++m) { const int row = row0 + ai * 128 + m * 16; bf16_t* rowp = P + (size_t)row * NP + col0; float sq = 0.f;
                const float rsx = rsxv[ai * 4 + m];
#pragma unroll
                for (int bj = 0; bj < 2; ++bj) { const int colg = u.pn * 256 + bj * 128; const float sc = (colg < 384 || (colg >= 1152 && colg < 1536)) ? C2 : 1.0f;
                    const f32x4 v0 = acc[ai][bj][m][0] * rsx, v1 = acc[ai][bj][m][1] * rsx;
                    if (u.pn == 9 || (u.pn == 10 && bj == 0)) sq += (v0[0] * v0[0] + v0[1] * v0[1]) + (v0[2] * v0[2] + v0[3] * v0[3]) + (v1[0] * v1[0] + v1[1] * v1[1]) + (v1[2] * v1[2] + v1[3] * v1[3]);
                    u32x4 w; w.x = cvt_pk(v0[0] * sc, v0[1] * sc); w.y = cvt_pk(v0[2] * sc, v0[3] * sc); w.z = cvt_pk(v1[0] * sc, v1[1] * sc); w.w = cvt_pk(v1[2] * sc, v1[3] * sc);
                    *(u32x4*)(rowp + bj * 128) = w; }
                if (want_sq) { sq += __shfl_xor(sq, 16); sq += __shfl_xor(sq, 32); if (fq == 0) (u.pn == 9 ? ssqq : ssqkv)[(size_t)row * 4 + wc] = sq; }
                if (u.pn == 10 && wc == 1 && fq == 0) { *(f32x4*)(flog + (size_t)row * 8) = acc[ai][1][m][0] * rsx; *(f32x4*)(flog + (size_t)row * 8 + 4) = acc[ai][1][m][1] * rsx; }
            }
    }
};
struct EpiMla {
    static constexpr bool PERM = false, AFTER_DRAIN = true, HAS_MID = false; static constexpr int MID0 = -1, MID1 = -1;
    bf16_t* QUP; bf16_t* KVUP; const float* ssqq; const float* ssqkv; const float* ct; const float* st; const LAS float* fac;
    __device__ __forceinline__ void rs_prelude(const pg8::Unit& u, int tid, LAS float* f) const {
        if (tid < 256) { const int row = u.pm * 256 + tid; const f32x4 sq4 = *(const f32x4*)(ssqq + (size_t)row * 4), sk4 = *(const f32x4*)(ssqkv + (size_t)row * 4);
            f[tid] = C2M / sqrtf(((sq4[0] + sq4[1]) + (sq4[2] + sq4[3])) * (1.f / 256.f) + EPS); f[256 + tid] = 1.0f / sqrtf(((sk4[0] + sk4[1]) + (sk4[2] + sk4[3])) * (1.f / 128.f) + EPS); }
    }
    __device__ __forceinline__ void mid(f32x4 (&)[2][2][4][2], int, int, int) const {}
    __device__ __forceinline__ void fused(const f32x4 (&acc)[2][2][4][2], const pg8::Unit& u, int wr, int wc, int fr, int fq, PG8_LAS unsigned char*, int, int) const { (*this)(acc, u, wr, wc, fr, fq); }
    __device__ __forceinline__ void operator()(const f32x4 (&acc)[2][2][4][2], const pg8::Unit& u, int wr, int wc, int fr, int fq) const {
        const int row0 = u.pm * 256 + wr * 64 + fr;
        const int g0_ = u.pn * 8 + wc, g1_ = g0_ + 4; const bool rope = (g0_ < 12 && g0_ % 3 == 2) || (g1_ < 12 && g1_ % 3 == 2);
#pragma unroll
        for (int ai = 0; ai < 2; ++ai) {
            f32x4 csv[4], snv[4];
            if (rope) {
#pragma unroll
                for (int m = 0; m < 4; ++m) { const int pos = (row0 + ai * 128 + m * 16) & (S - 1); csv[m] = *(const GAS f32x4*)(ct + pos * 16 + 4 * fq); snv[m] = *(const GAS f32x4*)(st + pos * 16 + 4 * fq); } }
#pragma unroll
            for (int m = 0; m < 4; ++m) { asm volatile("" ::: "memory"); const int row = row0 + ai * 128 + m * 16;
                const int rl = ai * 128 + wr * 64 + m * 16 + fr; const float rsq = fac[rl], rskv = fac[256 + rl];
#pragma unroll
                for (int bj = 0; bj < 2; ++bj) { const int g = u.pn * 8 + bj * 4 + wc;
                    f32x4 x0 = acc[ai][bj][m][0], x1 = acc[ai][bj][m][1];
                    if (g < 12) {
                        x0 = x0 * rsq; x1 = x1 * rsq;
                        if (g % 3 == 2) { const f32x4 cs = csv[m], sn = snv[m]; const f32x4 r0 = x0 * cs - x1 * sn, r1 = x0 * sn + x1 * cs; x0 = r0; x1 = r1; }
                        bf16_t* p = QUP + (size_t)row * 384 + g * 32 + 4 * fq;
                        u32x2 w0, w1; w0.x = cvt_pk(x0[0], x0[1]); w0.y = cvt_pk(x0[2], x0[3]); w1.x = cvt_pk(x1[0], x1[1]); w1.y = cvt_pk(x1[2], x1[3]);
                        *(u32x2*)p = w0; *(u32x2*)(p + 16) = w1;
                    } else if (g < 28) {
                        x0 = x0 * rskv; x1 = x1 * rskv;
                        bf16_t* p = KVUP + (size_t)row * 512 + (g - 12) * 32 + 4 * fq;
                        u32x2 w0, w1; w0.x = cvt_pk(x0[0], x0[1]); w0.y = cvt_pk(x0[2], x0[3]); w1.x = cvt_pk(x1[0], x1[1]); w1.y = cvt_pk(x1[2], x1[3]);
                        *(u32x2*)p = w0; *(u32x2*)(p + 16) = w1;
                    }
                }
            }
        }
    }
};
struct EpiWout {
    static constexpr bool PERM = false, AFTER_DRAIN = true, HAS_MID = true; static constexpr int MID0 = 6, MID1 = 10;
    const LAS float* fac;
    const bf16_t* xres; bf16_t* X1B; float* ssqx;
    __device__ __forceinline__ void fused(const f32x4 (&acc)[2][2][4][2], const pg8::Unit& u, int wr, int wc, int fr, int fq, PG8_LAS unsigned char*, int, int) const { (*this)(acc, u, wr, wc, fr, fq); }
    __device__ __forceinline__ void mid(f32x4 (&acc)[2][2][4][2], int t, int wr, int fr) const {
        const int seg = (t == MID0) ? 0 : 1;
#pragma unroll
        for (int ai = 0; ai < 2; ++ai)
#pragma unroll
            for (int m = 0; m < 4; ++m) { const float f = fac[seg * 256 + ai * 128 + wr * 64 + m * 16 + fr];
#pragma unroll
                for (int bj = 0; bj < 2; ++bj)
#pragma unroll
                    for (int n = 0; n < 2; ++n) acc[ai][bj][m][n] = acc[ai][bj][m][n] * f; }
    }
    __device__ __forceinline__ void operator()(const f32x4 (&acc)[2][2][4][2], const pg8::Unit& u, int wr, int wc, int fr, int fq) const {
        const int col0 = u.pn * 256 + wc * 32 + 4 * fq;
        u32x2 xr[4][4];
#define EW_LD(it_) do { const int row_ = u.pm * 256 + ((it_) >> 2) * 128 + wr * 64 + ((it_) & 3) * 16 + fr; \
            _Pragma("unroll") for (int q_ = 0; q_ < 4; ++q_) xr[(it_) & 3][q_] = *(const u32x2*)(xres + (size_t)row_ * D + col0 + (q_ >> 1) * 128 + (q_ & 1) * 16); } while (0)
        EW_LD(0); EW_LD(1); EW_LD(2);
#pragma unroll
        for (int it = 0; it < 8; ++it) { if (it + 3 < 8) EW_LD(it + 3);
            asm volatile("" ::: "memory"); const int ai = it >> 2, m = it & 3; const int rl = ai * 128 + wr * 64 + m * 16 + fr, row = u.pm * 256 + rl; const float f = fac[2 * 256 + rl]; float sq = 0.f;
#pragma unroll
            for (int bj = 0; bj < 2; ++bj)
#pragma unroll
                for (int n = 0; n < 2; ++n) { const size_t off = (size_t)row * D + col0 + bj * 128 + n * 16; const u32x2 xv = xr[it & 3][bj * 2 + n];
                    const f32x4 xf = (f32x4){__builtin_bit_cast(float, xv.x << 16), __builtin_bit_cast(float, xv.x & 0xffff0000u), __builtin_bit_cast(float, xv.y << 16), __builtin_bit_cast(float, xv.y & 0xffff0000u)};
                    const f32x4 v = acc[ai][bj][m][n] * f + xf;
                    u32x2 w; w.x = cvt_pk(v[0], v[1]); w.y = cvt_pk(v[2], v[3]); *(u32x2*)(X1B + off) = w;
                    sq += (v[0] * v[0] + v[1] * v[1]) + (v[2] * v[2] + v[3] * v[3]); }
            sq += __shfl_xor(sq, 16); sq += __shfl_xor(sq, 32);
            if (fq == 0) ssqx[(size_t)row * 16 + u.pn * 4 + wc] = sq; }
#undef EW_LD
    }
};
#ifndef MK_DBGSCORE
#define MK_DBGSCORE 0
#endif
#ifndef MK_DBGREV
#define MK_DBGREV 0
#endif
#ifndef MK_DBGONES
#define MK_DBGONES 0
#endif
#ifndef MK_VALUSCORE
#define MK_VALUSCORE 0
#endif
#ifndef MK_DBGSYN
#define MK_DBGSYN 0
#endif
#ifndef MK_DBGLIST
#define MK_DBGLIST 0
#endif
#ifndef MK_DBGQ
#define MK_DBGQ 0
#endif
__device__ __forceinline__ int crow(int r, int hi);
__device__ __forceinline__ unsigned fbits(float x) { return __builtin_bit_cast(unsigned, x); }
template <bool DESC> __device__ __forceinline__ void ce_(unsigned& x, unsigned& y) { const unsigned hi = x > y ? x : y, lo = x > y ? y : x; if (DESC) { x = hi; y = lo; } else { x = lo; y = hi; } }
template <bool DESC, int OFF, int N> __device__ __forceinline__ void bsort16(unsigned (&a)[N]) {
#pragma unroll
    for (int k = 2; k <= 16; k <<= 1)
#pragma unroll
        for (int j = k >> 1; j > 0; j >>= 1)
#pragma unroll
            for (int i = 0; i < 16; ++i) { const int l = i ^ j; if (l > i) { const bool up = ((i & k) == 0) || (k == 16); if (up) ce_<DESC>(a[OFF + i], a[OFF + l]); else ce_<!DESC>(a[OFF + i], a[OFF + l]); } }
}
template <bool DESC, int OFF, int N> __device__ __forceinline__ void bmerge16(unsigned (&a)[N]) {
#pragma unroll
    for (int j = 8; j > 0; j >>= 1)
#pragma unroll
        for (int i = 0; i < 16; ++i) { const int l = i ^ j; if (l > i) ce_<DESC>(a[OFF + i], a[OFF + l]); }
}
__device__ __forceinline__ void top16_of_64(unsigned (&a)[64]) {
    bsort16<true, 0>(a); bsort16<false, 16>(a); bsort16<true, 32>(a); bsort16<false, 48>(a);
#pragma unroll
    for (int i = 0; i < 16; ++i) { a[i] = a[i] > a[16 + i] ? a[i] : a[16 + i]; a[32 + i] = a[32 + i] > a[48 + i] ? a[32 + i] : a[48 + i]; }
    bmerge16<true, 0>(a); bmerge16<false, 32>(a);
#pragma unroll
    for (int i = 0; i < 16; ++i) a[i] = a[i] > a[32 + i] ? a[i] : a[32 + i];
    bmerge16<true, 0>(a);
}
__device__ __forceinline__ int key_index(unsigned k) { const unsigned c = k & 127u, hs = (c >> 6) & 1u, l6 = 63u - (c & 63u), blk = l6 >> 4, r = l6 & 15u; return (int)(32u * blk + (r & 3u) + 8u * (r >> 2) + 4u * hs); }
typedef float f32x16q __attribute__((ext_vector_type(16)));
struct EpiQ {
    static constexpr bool PERM = false, AFTER_DRAIN = true, HAS_MID = false; static constexpr int MID0 = -1, MID1 = -1;
    const float* ssqx; const bf16_t* keys;
    unsigned short* ids; float* gates; float* Qdbg; float* rsx; const LAS float* fac;
    __device__ __forceinline__ void rs_prelude(const pg8::Unit& u, int tid, LAS float* f) const {
        if (tid < 256) { const int row = u.pm * 256 + tid; const float* sp = ssqx + (size_t)row * 16;
            const f32x4 a = *(const f32x4*)sp, b = *(const f32x4*)(sp + 4), c = *(const f32x4*)(sp + 8), d = *(const f32x4*)(sp + 12);
            const float ss = ((a[0] + a[1]) + (a[2] + a[3])) + ((b[0] + b[1]) + (b[2] + b[3])) + ((c[0] + c[1]) + (c[2] + c[3])) + ((d[0] + d[1]) + (d[2] + d[3]));
            const float rs = 1.0f / sqrtf(ss * (1.f / D) + EPS);
            f[tid] = rs; if (u.pn == 0) rsx[row] = rs; }
    }
    __device__ __forceinline__ void mid(f32x4 (&)[2][2][4][2], int, int, int) const {}
    __device__ __forceinline__ void fused(const f32x4 (&acc)[2][2][4][2], const pg8::Unit& u, int wr, int wc, int fr, int fq, PG8_LAS unsigned char* lds, int wid, int lane) const {
#pragma unroll
        for (int ai = 0; ai < 2; ++ai)
#pragma unroll
            for (int m = 0; m < 4; ++m) { asm volatile("" ::: "memory"); const int rl = ai * 128 + wr * 64 + m * 16 + fr, row = u.pm * 256 + rl;
                const float rs = fac[rl];
#pragma unroll
                for (int bj = 0; bj < 2; ++bj)
#pragma unroll
                    for (int n = 0; n < 2; ++n) { const f32x4 v = acc[ai][bj][m][n] * rs; const int ch = 16 * bj + 4 * wc + 2 * n + (fq >> 1);
                        if (Qdbg && MK_DBGQ != 2) *(f32x4*)(Qdbg + (size_t)row * 2048 + u.pn * 256 + bj * 128 + wc * 32 + n * 16 + 4 * fq) = v;
                        u32x2 w; w.x = cvt_pk(v[0], v[1]); w.y = cvt_pk(v[2], v[3]);
                        *(PG8_LAS u32x2*)(lds + rl * 512 + ((ch ^ (rl & 15)) << 4) + (fq & 1) * 8) = w; } }
        asm volatile("s_waitcnt lgkmcnt(0)\n\ts_barrier" ::: "memory");
        const int r32 = lane & 31, hi = lane >> 5, tl = wid * 32 + r32;
        unsigned lst[16]; unsigned dbgS[16]; float dbgF[16];
#if MK_DBGLIST == 11
        { float hs = 0.f;
#pragma unroll
          for (int ks = 0; ks < 16; ++ks) { const bf16x8 kv = *(const bf16x8*)(keys + (size_t)r32 * 256 + 16 * ks + 8 * hi);
#pragma unroll
              for (int e = 0; e < 8; ++e) hs += __builtin_bit_cast(float, (unsigned)(unsigned short)kv[e] << 16); }
          auto rr = __builtin_amdgcn_permlane32_swap(__float_as_uint(hs), __float_as_uint(hs), false, false); const float tot = __uint_as_float(rr[0]) + __uint_as_float(rr[1]) + 32.0f;
#pragma unroll
          for (int k = 0; k < 16; ++k) dbgS[k] = __builtin_bit_cast(unsigned, tot); }
#endif
        bf16x8 ka[16];
        { const bf16_t* kr0 = keys + (size_t)lane * 8;
#pragma unroll
          for (int ks = 0; ks < 16; ++ks) ka[ks] = *(const bf16x8*)(kr0 + ks * 512); }
#pragma unroll 1
        for (int b = 0; b < 8; ++b) {
            f32x16q s0;
#pragma unroll
            for (int r = 0; r < 16; ++r) s0[r] = 32.0f;
            asm volatile("" : "+v"(s0));
#pragma unroll
            for (int ks = 0; ks < 16; ++ks) { const bf16x8 bq = *(const PG8_LAS bf16x8*)(lds + tl * 512 + (((2 * ks + hi) ^ (tl & 15)) << 4));
                s0 = __builtin_amdgcn_mfma_f32_32x32x16_bf16(ka[ks], bq, s0, 0, 0, 0); }
            { const bf16_t* kr = keys + (size_t)(b < 7 ? b + 1 : 7) * 8192 + (size_t)lane * 8;
#pragma unroll
              for (int ks = 0; ks < 16; ++ks) ka[ks] = *(const bf16x8*)(kr + ks * 512); }
#if MK_DBGLIST == 8
            if (b == 0) {
#pragma unroll
                for (int r = 0; r < 16; ++r) dbgS[r] = fbits(s0[r]); }
#endif
            unsigned nw[16];
#pragma unroll
            for (int r = 0; r < 16; ++r) nw[r] = (fbits(s0[r]) & ~127u) | ((unsigned)(127 - r) - (unsigned)(16 * b));
            bsort16<false, 0>(nw);
            if (b == 0) {
#pragma unroll
                for (int i = 0; i < 16; ++i) lst[i] = nw[15 - i];
            } else {
#pragma unroll
                for (int i = 0; i < 16; ++i) lst[i] = lst[i] > nw[i] ? lst[i] : nw[i];
                bmerge16<true, 0>(lst);
            }
        }
#if MK_DBGLIST == 9
        { float sv[16];
#pragma unroll
          for (int k = 0; k < 16; ++k) sv[k] = 32.0f;
#pragma unroll 1
          for (int c = 0; c < 16; ++c) { const u32x4 qv = *(const PG8_LAS u32x4*)(lds + tl * 512 + ((c ^ (tl & 15)) << 4));
#pragma unroll
              for (int k = 0; k < 16; ++k) { const u32x4 kv = *(const u32x4*)(keys + (size_t)(8 * (k >> 2) + (k & 3)) * 256 + 8 * c); float s = sv[k];
#pragma unroll
                  for (int e = 0; e < 4; ++e) { s = fmaf(__builtin_bit_cast(float, qv[e] << 16), __builtin_bit_cast(float, kv[e] << 16), s); s = fmaf(__builtin_bit_cast(float, qv[e] & 0xffff0000u), __builtin_bit_cast(float, kv[e] & 0xffff0000u), s); }
                  sv[k] = s; } }
#pragma unroll
          for (int k = 0; k < 16; ++k) dbgS[k] = __builtin_bit_cast(unsigned, sv[k]); }
#endif
        asm volatile("s_waitcnt lgkmcnt(0)\n\ts_barrier" ::: "memory");
        PG8_LAS unsigned* tk = (PG8_LAS unsigned*)(lds + wid * (32 * 36 * 4)) + r32 * 36;
#pragma unroll
        for (int i4 = 0; i4 < 4; ++i4) *(PG8_LAS u32x4*)(tk + 16 * hi + 4 * i4) = (u32x4){lst[4 * i4], lst[4 * i4 + 1], lst[4 * i4 + 2], lst[4 * i4 + 3]};
        asm volatile("s_waitcnt lgkmcnt(0)" ::: "memory");
        unsigned s1k[16], s2k[16];
#pragma unroll
        for (int i4 = 0; i4 < 4; ++i4) { const u32x4 x = *(const PG8_LAS u32x4*)(tk + 4 * i4), y = *(const PG8_LAS u32x4*)(tk + 16 + 4 * i4);
#pragma unroll
            for (int e = 0; e < 4; ++e) { s1k[4 * i4 + e] = x[e]; s2k[4 * i4 + e] = y[e]; } }
        unsigned cd[64];
        { int n = 0;
#pragma unroll
          for (int i = 0; i < 16; ++i)
#pragma unroll
              for (int j = 0; j < 16; ++j) if ((i + 1) * (j + 1) <= 16) { const float s = __builtin_bit_cast(float, s1k[i] & ~127u) + __builtin_bit_cast(float, s2k[j] & ~127u);
                  cd[n] = (__builtin_bit_cast(unsigned, s) & ~255u) | (unsigned)(255 - (16 * i + j)); ++n; }
#pragma unroll
          for (int i = 50; i < 64; ++i) cd[i] = 0u; }
        top16_of_64(cd);
        float val[16]; int eid[16]; float mx = -INFINITY;
#pragma unroll
        for (int k = 0; k < 16; ++k) { const unsigned code = 255u - (cd[k] & 255u), i = code >> 4, j = code & 15u; const unsigned k1 = tk[i], k2 = tk[16 + j];
            val[k] = __builtin_bit_cast(float, k1 & ~127u) + __builtin_bit_cast(float, k2 & ~127u); eid[k] = (int)(127u - (k1 & 127u)) * 128 + (int)(127u - (k2 & 127u)); mx = fmaxf(mx, val[k]); }
#if MK_DBGLIST == 8 || MK_DBGLIST == 9 || MK_DBGLIST == 11
#pragma unroll
        for (int k = 0; k < 16; ++k) eid[k] = (int)dbgS[k];
#endif
#if MK_DBGLIST == 10
#pragma unroll
        for (int k = 0; k < 16; ++k) eid[k] = __builtin_bit_cast(int, dbgF[k]);
#endif
        float sum = 0.f;
#pragma unroll
        for (int k = 0; k < 16; ++k) { val[k] = __builtin_amdgcn_exp2f((val[k] - mx) * LOG2E); sum += val[k]; }
        const float inv = 1.0f / sum;
        const size_t ob = ((size_t)(u.pm * 256 + tl) * 8 + u.pn) * 16;
        if (hi == 0) {
#pragma unroll
            for (int k4 = 0; k4 < 2; ++k4) *(u32x4*)(ids + ob + 8 * k4) = (u32x4){(unsigned)eid[8 * k4] | ((unsigned)eid[8 * k4 + 1] << 16), (unsigned)eid[8 * k4 + 2] | ((unsigned)eid[8 * k4 + 3] << 16), (unsigned)eid[8 * k4 + 4] | ((unsigned)eid[8 * k4 + 5] << 16), (unsigned)eid[8 * k4 + 6] | ((unsigned)eid[8 * k4 + 7] << 16)};
        } else {
#pragma unroll
            for (int k4 = 0; k4 < 4; ++k4) *(f32x4*)(gates + ob + 4 * k4) = (f32x4){val[4 * k4] * inv, val[4 * k4 + 1] * inv, val[4 * k4 + 2] * inv, val[4 * k4 + 3] * inv};
        }
        asm volatile("s_waitcnt lgkmcnt(0)\n\ts_barrier" ::: "memory");
    }
};
struct OneUnit { pg8::StaticOrder S; int i;
    __device__ __forceinline__ bool next(int j, pg8::Unit& u) const { return j == 0 ? S.next(i, u) : false; }
    __device__ __forceinline__ void a_ready(const pg8::Unit&) const {}
    __device__ __forceinline__ void done(const pg8::Unit&) const {} };
}

namespace fx {
typedef short s16x4 __attribute__((ext_vector_type(4)));
typedef float f32x16 __attribute__((ext_vector_type(16)));
typedef LAS const char* lds_cptr;
typedef short v4i16_t __attribute__((ext_vector_type(4)));
#define AT_MFMA(a, b, c) __builtin_amdgcn_mfma_f32_32x32x16_bf16(a, b, c, 0, 0, 0)
__device__ __forceinline__ int crow(int r, int hi) { return (r & 3) + 8 * (r >> 2) + 4 * hi; }
__device__ __forceinline__ void glds16(const void* gsrc, unsigned lds_dst) { unsigned keep;
    asm volatile("s_mov_b32 %0, m0\n\ts_mov_b32 m0, %2\n\ts_nop 0\n\tglobal_load_lds_dwordx4 %1, off\n\ts_mov_b32 m0, %0" : "=&s"(keep) : "v"(gsrc), "s"(lds_dst) : "memory"); }
__device__ __forceinline__ s16x4 vtr(lds_cptr p) { return __builtin_bit_cast(s16x4, __builtin_amdgcn_ds_read_tr16_b64_v4i16((LAS v4i16_t*)p)); }
__device__ __forceinline__ float swap_sum(float v) { auto rr = __builtin_amdgcn_permlane32_swap(__float_as_uint(v), __float_as_uint(v), false, false); return __uint_as_float(rr[0]) + __uint_as_float(rr[1]); }
__device__ __forceinline__ float swap_max(float v) { auto rr = __builtin_amdgcn_permlane32_swap(__float_as_uint(v), __float_as_uint(v), false, false); return fmaxf(__uint_as_float(rr[0]), __uint_as_float(rr[1])); }

#ifndef MK_ABL
#define MK_ABL 0
#endif
struct AttnP { const bf16_t *Q, *K, *KX, *V; int ldq, ldk, ldkx, ldv; bf16_t* O; float* ssq; int abl; };

constexpr int AT_SLOTV = 8192;
constexpr float AT_THR = 8.0f;
template <int MODE, int NX, int QX>
__device__ __forceinline__ void attn_unit(const AttnP& U, int qb, LAS unsigned char* ldsb) {
    constexpr int ND0 = 4 + NX / 2, KSL = (8 + NX) * 1024, LV0 = 3 * KSL, LWS = LV0 + 3 * AT_SLOTV, LOST = LWS + 8 * 256;
    constexpr int LDONE = LOST + 8 * 4096;
    static_assert(LDONE + 64 <= RING_BYTES, "attention LDS");
    int tid_ = threadIdx.x; asm volatile("" : "+v"(tid_));
    const int tid = tid_, lane = tid & 63, r32 = lane & 31, hi = lane >> 5; const int wid = __builtin_amdgcn_readfirstlane(tid >> 6);
    const int q0 = qb * 256, NT = 4 * qb + 4, tdiag = 4 * qb + (wid >> 1);
    const unsigned lds0 = (unsigned)(uintptr_t)ldsb;
    LAS float* wsf = (LAS float*)(ldsb + LWS) + wid * 64;
    const bf16_t* ksrc = U.K + (size_t)(8 * wid + (lane >> 3)) * U.ldk + (((lane & 7) ^ (((8 * wid + (lane >> 3)) >> 1) & 7)) * 8);
    const bf16_t* kxsrc = (NX > 0) ? U.KX + (size_t)lane * U.ldkx + (wid & 3) * 8 : nullptr;
    const bf16_t* vsrc = U.V + (size_t)(16 * (wid & 3) + (lane >> 2)) * U.ldv + (wid >> 2) * 32 + (lane & 3) * 8;
    const unsigned kdst = lds0 + wid * 1024, kxdst = lds0 + (8 + (wid & 3)) * 1024, vdst = lds0 + LV0 + wid * 1024;
#define AT_DMA(t, s) do { glds16(ksrc + (size_t)(t) * 64 * U.ldk, (unsigned)__builtin_amdgcn_readfirstlane(kdst + (s) * KSL)); \
        if (NX > 0 && wid < NX) glds16(kxsrc + (size_t)(t) * 64 * U.ldkx, (unsigned)__builtin_amdgcn_readfirstlane(kxdst + (s) * KSL)); \
        glds16(vsrc + (size_t)(t) * 64 * U.ldv, (unsigned)__builtin_amdgcn_readfirstlane(vdst + (s) * AT_SLOTV)); } while (0)
#define AT_TILE(i) ((MODE == 0) ? (i) : (NT - 1 - (i)))
    AT_DMA(AT_TILE(0), 0); if (NT > 1) AT_DMA(AT_TILE(1), 1);
    bf16x8 qr[ND0];
    { const bf16_t* Qw = U.Q + (size_t)(q0 + wid * 32 + r32) * U.ldq + hi * 8;
#pragma unroll
      for (int d0 = 0; d0 < 4; ++d0) qr[d0] = *(const bf16x8*)(Qw + d0 * 16);
      if (QX == 2) {
#pragma unroll
          for (int d0 = 4; d0 < ND0; ++d0) qr[d0] = *(const bf16x8*)(Qw + d0 * 16);
      } else if (QX == 1) {
          const short one = (short)0x3F80; qr[4] = (bf16x8){0, 0, 0, 0, 0, 0, 0, 0}; if (hi == 0) { qr[4][0] = one; qr[4][1] = one; }
      } }
#pragma unroll
    for (int d0 = 0; d0 < ND0; ++d0) asm volatile("" : "+v"(qr[d0]));
    f32x16 o[2]; o[0] = f32x16{}; o[1] = f32x16{};
    f32x16 negm = f32x16{};
    float mhat = 0.f, l_reg = 0.f, Rc = 0.f; bool first = true;
    const lds_cptr kp0 = (lds_cptr)ldsb + hi * 1024 + r32 * 16;
    const lds_cptr kpm = (lds_cptr)ldsb + r32 * 128; const int kswz = (r32 >> 1) & 7;
    const lds_cptr vp0 = (lds_cptr)ldsb + LV0 + ((lane >> 4) & 1) * 32 + (lane & 3) * 8 + (4 * hi + ((lane & 15) >> 2)) * 64;
    const int qrel = 32 * (wid & 1) + r32;
    int sl = 0; bool wdone = false;
    volatile LAS int* dstamp = (volatile LAS int*)(ldsb + LDONE);
    if (MODE == 1 && lane == 0) dstamp[wid] = 0x7fffffff;
    for (int i = 0; i < NT; ++i) {
        const int t = AT_TILE(i);
        if (i + 1 < NT) { if (NX > 0 && wid < NX) asm volatile("s_waitcnt vmcnt(3) lgkmcnt(0)\n\ts_barrier" ::: "memory"); else asm volatile("s_waitcnt vmcnt(2) lgkmcnt(0)\n\ts_barrier" ::: "memory"); }
        else asm volatile("s_waitcnt vmcnt(0) lgkmcnt(0)\n\ts_barrier" ::: "memory");
        if (MODE == 1) {
            int mx = dstamp[0];
#pragma unroll
            for (int w = 1; w < 8; ++w) { const int v = dstamp[w]; mx = v > mx ? v : mx; }
            if (mx < i) break; }
        if (i + 2 < NT) { const int s2 = (sl >= 1) ? sl - 1 : 2; AT_DMA(AT_TILE(i + 2), s2); }
        if (t <= tdiag && !(MODE == 1 && wdone)) {
            const lds_cptr kp = kp0 + sl * KSL; const lds_cptr vp = vp0 + sl * AT_SLOTV;
            f32x16 p0, p1;
            if (MODE == 0) { p0 = negm; p1 = negm; } else { p0 = f32x16{}; p1 = f32x16{}; }
#pragma unroll
            for (int d0 = 0; d0 < ND0; ++d0) { if (MK_ABL && U.abl == 3) break;
                const lds_cptr ka_ = (d0 < 4) ? kpm + sl * KSL + (((2 * d0 + hi) ^ kswz) << 4) : kp + d0 * 2048; const int kstep = (d0 < 4) ? 4096 : 512;
                const bf16x8 k0 = *(const LAS bf16x8*)(ka_), k1 = *(const LAS bf16x8*)(ka_ + kstep);
                p0 = AT_MFMA(k0, qr[d0], p0); p1 = AT_MFMA(k1, qr[d0], p1); }
            if (MK_ABL && U.abl == 1) { } else
            if (MODE == 0) {
                if (t == tdiag) {
#pragma unroll
                    for (int r = 0; r < 16; ++r) { const int kv = crow(r, hi); if (kv > qrel) p0[r] = -INFINITY; if (kv + 32 > qrel) p1[r] = -INFINITY; } }
                float rm = fmaxf(p0[0], p1[0]);
#pragma unroll
                for (int r = 1; r < 16; ++r) rm = fmaxf(rm, fmaxf(p0[r], p1[r]));
                rm = swap_max(rm);
                if (first) { mhat = rm;
#pragma unroll
                    for (int r = 0; r < 16; ++r) { p0[r] -= rm; p1[r] -= rm; negm[r] = -mhat; }
                    first = false;
                } else if (__any(rm > AT_THR)) { const float dl = fmaxf(rm, 0.f); mhat += dl;
#pragma unroll
                    for (int r = 0; r < 16; ++r) { p0[r] -= dl; p1[r] -= dl; negm[r] = -mhat; }
                    const float f = __builtin_amdgcn_exp2f(-dl); l_reg *= f; if (hi == 0) wsf[r32] = f;
#pragma unroll
                    for (int g = 0; g < 4; ++g) { const f32x4 fv = *(const LAS f32x4*)(wsf + 8 * g + 4 * hi);
#pragma unroll
                        for (int e = 0; e < 4; ++e) { o[0][4 * g + e] *= fv[e]; o[1][4 * g + e] *= fv[e]; } }
                }
                float sacc = 0.f;
#pragma unroll
                for (int r = 0; r < 16; ++r) { p0[r] = __builtin_amdgcn_exp2f(p0[r]); p1[r] = __builtin_amdgcn_exp2f(p1[r]); sacc += p0[r] + p1[r]; }
                l_reg += sacc;
            } else {
                f32x16 lk0, lk1;
#pragma unroll
                for (int r = 0; r < 16; ++r) {
                    { const float z = p0[r]; const float e = __builtin_amdgcn_exp2f(-fabsf(z)); lk0[r] = -(fmaxf(z, 0.f) + __builtin_amdgcn_logf(1.0f + e)); }
                    { const float z = p1[r]; const float e = __builtin_amdgcn_exp2f(-fabsf(z)); lk1[r] = -(fmaxf(z, 0.f) + __builtin_amdgcn_logf(1.0f + e)); } }
                if (t == tdiag) {
#pragma unroll
                    for (int r = 0; r < 16; ++r) { const int kv = crow(r, hi); if (kv >= qrel) { lk0[r] = 0.f; p0[r] = -INFINITY; } if (kv + 32 >= qrel) { lk1[r] = 0.f; p1[r] = -INFINITY; } } }
                float Bo[8], T[8];
#pragma unroll
                for (int j = 0; j < 4; ++j) { Bo[j] = (lk0[4 * j] + lk0[4 * j + 1]) + (lk0[4 * j + 2] + lk0[4 * j + 3]); Bo[4 + j] = (lk1[4 * j] + lk1[4 * j + 1]) + (lk1[4 * j + 2] + lk1[4 * j + 3]); }
#pragma unroll
                for (int j = 0; j < 8; ++j) T[j] = swap_sum(Bo[j]);
                float sfx = Rc;
#pragma unroll
                for (int j = 7; j >= 0; --j) { float off = sfx + (hi == 0 ? (T[j] - Bo[j]) : 0.f); sfx += T[j];
                    if (j < 4) { float s3 = off, s2 = s3 + lk0[4 * j + 3], s1 = s2 + lk0[4 * j + 2], s0 = s1 + lk0[4 * j + 1];
                        p0[4 * j + 3] = __builtin_amdgcn_exp2f(p0[4 * j + 3] + lk0[4 * j + 3] + s3); p0[4 * j + 2] = __builtin_amdgcn_exp2f(p0[4 * j + 2] + lk0[4 * j + 2] + s2);
                        p0[4 * j + 1] = __builtin_amdgcn_exp2f(p0[4 * j + 1] + lk0[4 * j + 1] + s1); p0[4 * j + 0] = __builtin_amdgcn_exp2f(p0[4 * j + 0] + lk0[4 * j + 0] + s0);
                    } else { const int jj = j - 4; float s3 = off, s2 = s3 + lk1[4 * jj + 3], s1 = s2 + lk1[4 * jj + 2], s0 = s1 + lk1[4 * jj + 1];
                        p1[4 * jj + 3] = __builtin_amdgcn_exp2f(p1[4 * jj + 3] + lk1[4 * jj + 3] + s3); p1[4 * jj + 2] = __builtin_amdgcn_exp2f(p1[4 * jj + 2] + lk1[4 * jj + 2] + s2);
                        p1[4 * jj + 1] = __builtin_amdgcn_exp2f(p1[4 * jj + 1] + lk1[4 * jj + 1] + s1); p1[4 * jj + 0] = __builtin_amdgcn_exp2f(p1[4 * jj + 0] + lk1[4 * jj + 0] + s0); }
                }
                Rc = sfx;
                if (__all(Rc < -150.0f)) { wdone = true; if (lane == 0) dstamp[wid] = i; }
            }
            u32x4 pw[4];
#pragma unroll
            for (int k = 0; k < 2; ++k) { pw[k] = (u32x4){cvt_pk(p0[8 * k], p0[8 * k + 1]), cvt_pk(p0[8 * k + 2], p0[8 * k + 3]), cvt_pk(p0[8 * k + 4], p0[8 * k + 5]), cvt_pk(p0[8 * k + 6], p0[8 * k + 7])};
                pw[2 + k] = (u32x4){cvt_pk(p1[8 * k], p1[8 * k + 1]), cvt_pk(p1[8 * k + 2], p1[8 * k + 3]), cvt_pk(p1[8 * k + 4], p1[8 * k + 5]), cvt_pk(p1[8 * k + 6], p1[8 * k + 7])}; }
#pragma unroll
            for (int dh = 0; dh < 2; ++dh)
#pragma unroll
                for (int ks = 0; ks < 4; ++ks) { if (MK_ABL && U.abl == 2) break; const s16x4 lo = vtr(vp + dh * 4096 + ks * 1024), hh = vtr(vp + dh * 4096 + ks * 1024 + 512);
                    const bf16x8 vf = (bf16x8){lo[0], lo[1], lo[2], lo[3], hh[0], hh[1], hh[2], hh[3]};
                    o[dh] = AT_MFMA(__builtin_bit_cast(bf16x8, pw[ks]), vf, o[dh]); }
        }
        sl = (sl == 2) ? 0 : sl + 1;
    }
    float rli[16];
    if (MODE == 0) { const float lt = swap_sum(l_reg); if (hi == 0) wsf[32 + r32] = lt;
#pragma unroll
        for (int g = 0; g < 4; ++g) { const f32x4 lv = *(const LAS f32x4*)(wsf + 32 + 8 * g + 4 * hi);
#pragma unroll
            for (int e = 0; e < 4; ++e) rli[4 * g + e] = __builtin_amdgcn_rcpf(lv[e]); }
    } else {
#pragma unroll
        for (int r = 0; r < 16; ++r) rli[r] = 1.0f; }
    { LAS bf16_t* stg = (LAS bf16_t*)(ldsb + LOST) + wid * 2048;
#pragma unroll
      for (int r = 0; r < 16; ++r) { const int orow = crow(r, hi);
#pragma unroll
          for (int dh = 0; dh < 2; ++dh) stg[orow * 64 + dh * 32 + r32] = (bf16_t)f2bf(o[dh][r] * rli[r]); }
      bf16_t* Ow = U.O + (size_t)(q0 + wid * 32) * D;
#pragma unroll
      for (int ii = 0; ii < 4; ++ii) { const int row = ii * 8 + (lane >> 3), ch = lane & 7; const u32x4 v = *(const LAS u32x4*)(stg + row * 64 + ch * 8);
          *(u32x4*)(Ow + (size_t)row * D + ch * 8) = v;
          float sq = 0.f;
#pragma unroll
          for (int e = 0; e < 4; ++e) { const float a = __builtin_bit_cast(float, v[e] << 16), b = __builtin_bit_cast(float, v[e] & 0xffff0000u); sq += a * a + b * b; }
          sq += __shfl_xor(sq, 1); sq += __shfl_xor(sq, 2); sq += __shfl_xor(sq, 4);
          if (ch == 0) U.ssq[(size_t)(q0 + wid * 32 + row) * 16] = sq; } }
    asm volatile("s_waitcnt vmcnt(0) lgkmcnt(0)\n\ts_barrier" ::: "memory");
#undef AT_DMA
#undef AT_TILE
}

#ifndef AT_MASK
#define AT_MASK 7
#endif
__device__ __forceinline__ unsigned attn_pop(Frame& F, int qi) {
    if (F.tid == 0) F.MISC[16] = __hip_atomic_fetch_add((unsigned*)(F.ctl + CW_ATTQ + 64 * qi), 1u, RLX_AGENT);
    asm volatile("s_waitcnt vmcnt(0) lgkmcnt(0)\n\ts_barrier" ::: "memory");
    const unsigned u = F.MISC[16];
    asm volatile("s_waitcnt lgkmcnt(0)\n\ts_barrier" ::: "memory");
    return u;
}
#ifndef MK_CONVQ
#define MK_CONVQ 1
#endif
__device__ __forceinline__ void conv_unit(Frame& F, int cu) {
    const int t = cu >> 8, c = cu & 255, lane = F.lane;
    const GAS f32x4* src = (const GAS f32x4*)F.a->in[16 + t]; GAS unsigned* dst = (GAS unsigned*)(F.ws + (t ? WS_VB : WS_UB)); const float sc = t ? 8.0f : 64.0f;
#pragma unroll 1
    for (int rb = 0; rb < 16; rb += 8) {
        f32x4 x[8][4];
#pragma unroll
        for (int q = 0; q < 8; ++q) { const size_t rr = (size_t)c * 128 + F.wave * 16 + rb + q;
#pragma unroll
            for (int j = 0; j < 4; ++j) x[q][j] = src[rr * 256 + 64 * j + lane]; }
#pragma unroll
        for (int q = 0; q < 8; ++q) { const size_t rr = (size_t)c * 128 + F.wave * 16 + rb + q, l2 = rr >> 14, r = rr & 16383;
#pragma unroll
            for (int j = 0; j < 4; ++j) { const f32x4 v = x[q][j] * sc; int w = __builtin_amdgcn_cvt_pk_fp8_f32(v[0], v[1], 0, false); w = __builtin_amdgcn_cvt_pk_fp8_f32(v[2], v[3], w, true);
                dst[((l2 * 8 + 2 * j + (lane >> 5)) * 16384 + r) * 32 + (lane & 31)] = (unsigned)w; } }
    }
}
__device__ __forceinline__ void attn_phase(Frame& F, int l) {
    const int tmask = ((F.a->pad >> 4) & 7) ? ((F.a->pad >> 4) & 7) : 7;
    const bool conv = MK_CONVQ && l == 0;
    const unsigned nconv = conv ? 512u - min(512u, __hip_atomic_load((unsigned*)(F.ctl + CW_ATTQ + 64 * 6), RLX_AGENT)) : 0u;
    const unsigned NTOT = conv ? 1536u : 1024u;
    for (;;) {
        const unsigned u = attn_pop(F, l * 3 + 1); if (u >= NTOT) break;
        unsigned a = u;
        if (conv) { if (u % 3u == 2u) { if (u / 3u < nconv) conv_unit(F, (int)(u / 3u)); continue; } a = 2u * (u / 3u) + u % 3u; }
        if (a < 640u) {
            const int qb = 7 - (int)(a / 80u), r = (int)(a % 80u);
            if (r < 32) {
                if (!((AT_MASK & 4) && (tmask & 4))) continue;
                const int b = r / 4, h = r % 4; const size_t r0 = (size_t)b * S;
                AttnP P;
                P.Q = wsp<bf16_t>(F, WS_QUP) + r0 * 384 + 96 * h; P.ldq = 384; P.K = wsp<bf16_t>(F, WS_KVUP) + r0 * 512 + 128 * h; P.V = P.K + 64; P.ldk = P.ldv = 512;
                P.KX = wsp<bf16_t>(F, WS_KR) + r0 * 32; P.ldkx = 32;
                P.O = wsp<bf16_t>(F, WS_Y) + r0 * D + 384 + 64 * h; P.ssq = wsp<float>(F, WS_SSQH) + r0 * 16 + 6 + h;
                P.abl = (F.a->pad >> 8) & 7; if (MK_ABL && ((F.a->pad >> 7) & 1)) { P.O = wsp<bf16_t>(F, WS_PART) + r0 * D + 384 + 64 * h; P.ssq = wsp<float>(F, WS_PART + 64 * MiB) + r0 * 16 + 6 + h; }
                attn_unit<0, 4, 2>(P, qb, F.lds);
            } else {
                if (!((AT_MASK & 2) && (tmask & 2))) continue;
                const int idx = r - 32, b = idx / 6, h = idx % 6; const size_t r0 = (size_t)b * S;
                bf16_t* PROJ = wsp<bf16_t>(F, WS_PROJ); AttnP P;
                P.Q = PROJ + r0 * NP + PC_FQ + 64 * h; P.K = PROJ + r0 * NP + PC_FK + 64 * h; P.V = PROJ + r0 * NP + PC_FV + 64 * h; P.ldq = P.ldk = P.ldv = NP;
                P.KX = wsp<bf16_t>(F, WS_KEXT) + r0 * 96 + 16 * h; P.ldkx = 96;
                P.O = wsp<bf16_t>(F, WS_Y) + r0 * D + 64 * h; P.ssq = wsp<float>(F, WS_SSQH) + r0 * 16 + h;
                P.abl = (F.a->pad >> 8) & 7; if (MK_ABL && ((F.a->pad >> 7) & 1)) { P.O = wsp<bf16_t>(F, WS_PART) + r0 * D + 64 * h; P.ssq = wsp<float>(F, WS_PART + 64 * MiB) + r0 * 16 + h; }
                attn_unit<0, 2, 1>(P, qb, F.lds);
            }
        } else {
            if (!((AT_MASK & 1) && (tmask & 1))) continue;
            const unsigned v = a - 640u;
            const int qb = 7 - (int)(v / 48u), idx = (int)(v % 48u), b = idx / 6, h = idx % 6; const size_t r0 = (size_t)b * S;
            bf16_t* PROJ = wsp<bf16_t>(F, WS_PROJ); AttnP P;
            P.Q = PROJ + r0 * NP + PC_SQ + 64 * h; P.K = PROJ + r0 * NP + PC_SK + 64 * h; P.V = PROJ + r0 * NP + PC_SV + 64 * h; P.KX = nullptr; P.ldq = P.ldk = P.ldv = NP; P.ldkx = 0;
            P.O = wsp<bf16_t>(F, WS_Y) + r0 * D + 640 + 64 * h; P.ssq = wsp<float>(F, WS_SSQH) + r0 * 16 + 10 + h;
            P.abl = (F.a->pad >> 8) & 7; if (MK_ABL && ((F.a->pad >> 7) & 1)) { P.O = wsp<bf16_t>(F, WS_PART) + r0 * D + 640 + 64 * h; P.ssq = wsp<float>(F, WS_PART + 64 * MiB) + r0 * 16 + 10 + h; }
            attn_unit<1, 0, 0>(P, qb, F.lds);
        }
    }
}

__device__ __forceinline__ float logsig(float x) { return fminf(x, 0.f) - log1pf(expf(-fabsf(x))); }
__device__ __forceinline__ void prep_phase(Frame& F, int l) {
    const int gw = F.vcu * NWAVES + F.wave, NGW = F.G * NWAVES, lane = F.lane;
    const float* flog = wsp<float>(F, WS_FLOG); const float* fb = F.a->in[3] + l * 6; bf16_t* KEXT = wsp<bf16_t>(F, WS_KEXT);
    if (F.wave == 0 && (int)blockIdx.x < B * 6) {
        const int b = (int)blockIdx.x / 6, h = (int)blockIdx.x % 6; const float bias = fb[h]; const size_t r0 = (size_t)b * S + lane * 32;
        float lf[32];
#pragma unroll
        for (int i = 0; i < 32; ++i) lf[i] = flog[(r0 + i) * 8 + h];
        float tot = 0.f;
#pragma unroll
        for (int i = 0; i < 32; ++i) { lf[i] = logsig(lf[i] + bias); tot += lf[i]; }
        float incl = tot;
#pragma unroll
        for (int o = 1; o < 64; o <<= 1) { const float n = __shfl_up(incl, o); if (lane >= o) incl += n; }
        float c = incl - tot;
#pragma unroll
        for (int i = 0; i < 32; ++i) { c += lf[i]; const float val = -c * LOG2E; const unsigned hb = f2bf(val); const float hf = __builtin_bit_cast(float, hb << 16); const unsigned lb = f2bf(val - hf);
            v4u w0 = {hb | (lb << 16), 0u, 0u, 0u}, w1 = {0u, 0u, 0u, 0u}; GAS v4u* dst = (GAS v4u*)(KEXT + (r0 + i) * 96 + 16 * h); dst[0] = w0; dst[1] = w1; }
    }
    const bf16_t* PROJ = wsp<bf16_t>(F, WS_PROJ); bf16_t* KR = wsp<bf16_t>(F, WS_KR); const float* ct = wsp<float>(F, WS_ROPE); const float* st = ct + 2048 * 16;
    for (int i = gw * 64 + lane; i < M * 16; i += NGW * 64) { const int row = i >> 4, j = i & 15, pos = row & (S - 1);
        const float x1 = bf2f(PROJ[(size_t)row * NP + PC_KR + j]), x2 = bf2f(PROJ[(size_t)row * NP + PC_KR + 16 + j]); const float cs = ct[pos * 16 + j], sn = st[pos * 16 + j];
        KR[(size_t)row * 32 + j] = (bf16_t)f2bf(x1 * cs - x2 * sn); KR[(size_t)row * 32 + 16 + j] = (bf16_t)f2bf(x1 * sn + x2 * cs); }
}

__device__ __forceinline__ void route_item(const float* q, const float* keys1, const float* keys2, int* ids, float* gates, int lane) {
    float s1a = 0.f, s1b = 0.f, s2a = 0.f, s2b = 0.f;
    for (int d = 0; d < 128; d += 4) {
        const f32x4 qa = *(const f32x4*)(q + d), qb = *(const f32x4*)(q + 128 + d);
        const f32x4 k1a = *(const f32x4*)(keys1 + lane * 128 + d), k1b = *(const f32x4*)(keys1 + (lane + 64) * 128 + d);
        const f32x4 k2a = *(const f32x4*)(keys2 + lane * 128 + d), k2b = *(const f32x4*)(keys2 + (lane + 64) * 128 + d);
        s1a += qa.x * k1a.x + qa.y * k1a.y + qa.z * k1a.z + qa.w * k1a.w; s1b += qa.x * k1b.x + qa.y * k1b.y + qa.z * k1b.z + qa.w * k1b.w;
        s2a += qb.x * k2a.x + qb.y * k2a.y + qb.z * k2a.z + qb.w * k2a.w; s2b += qb.x * k2b.x + qb.y * k2b.y + qb.z * k2b.z + qb.w * k2b.w;
    }
    float top1 = 0.f, top2 = 0.f; int idx1 = 0, idx2 = 0;
#pragma unroll
    for (int side = 0; side < 2; ++side) {
        float v0 = side ? s2a : s1a, v1 = side ? s2b : s1b; float tp = 0.f; int ti = 0;
        for (int k = 0; k < 16; ++k) {
            float bv; int bi; if (v0 >= v1) { bv = v0; bi = lane; } else { bv = v1; bi = lane + 64; }
#pragma unroll
            for (int o = 32; o >= 1; o >>= 1) { const float ov = __shfl_xor(bv, o); const int oi = __shfl_xor(bi, o); if (ov > bv || (ov == bv && oi < bi)) { bv = ov; bi = oi; } }
            if (lane == k) { tp = bv; ti = bi; }
            if (bi == lane) v0 = -INFINITY; if (bi == lane + 64) v1 = -INFINITY;
        }
        if (side) { top2 = tp; idx2 = ti; } else { top1 = tp; idx1 = ti; }
    }
    const float a = __shfl(top1, lane >> 2); const int ia = __shfl(idx1, lane >> 2);
    float c0, c1, c2, c3; int e0, e1, e2, e3;
    { const int jb = (lane & 3) * 4;
      c0 = a + __shfl(top2, jb + 0); e0 = ia * 128 + __shfl(idx2, jb + 0);
      c1 = a + __shfl(top2, jb + 1); e1 = ia * 128 + __shfl(idx2, jb + 1);
      c2 = a + __shfl(top2, jb + 2); e2 = ia * 128 + __shfl(idx2, jb + 2);
      c3 = a + __shfl(top2, jb + 3); e3 = ia * 128 + __shfl(idx2, jb + 3); }
    float best = 0.f; int bid = 0;
    for (int k = 0; k < 16; ++k) {
        float bv = c0; int bc = lane * 4, be = e0;
        if (c1 > bv) { bv = c1; bc = lane * 4 + 1; be = e1; }
        if (c2 > bv) { bv = c2; bc = lane * 4 + 2; be = e2; }
        if (c3 > bv) { bv = c3; bc = lane * 4 + 3; be = e3; }
#pragma unroll
        for (int o = 32; o >= 1; o >>= 1) { const float ov = __shfl_xor(bv, o); const int oc = __shfl_xor(bc, o), oe = __shfl_xor(be, o); if (ov > bv || (ov == bv && oc < bc)) { bv = ov; bc = oc; be = oe; } }
        if (lane == k) { best = bv; bid = be; }
        if (bc == lane * 4) c0 = -INFINITY; if (bc == lane * 4 + 1) c1 = -INFINITY; if (bc == lane * 4 + 2) c2 = -INFINITY; if (bc == lane * 4 + 3) c3 = -INFINITY;
    }
    const float mx = __shfl(best, 0);
    const float e = (lane < 16) ? expf(best - mx) : 0.f;
    const float sum = wave_sum(e);
    if (lane < 16) { ids[lane] = bid; gates[lane] = e / sum; }
}
__device__ __forceinline__ void route_phase(Frame& F, int l) {
    const int gw = F.vcu * NWAVES + F.wave, NGW = F.G * NWAVES;
    const float* Q = wsp<float>(F, WS_QF); const float* k1 = F.a->in[14] + (size_t)l * 16384; const float* k2 = F.a->in[15] + (size_t)l * 16384;
    int* ids = wsp<int>(F, WS_IDS); float* gates = wsp<float>(F, WS_GATES);
    for (int it = gw; it < M * 8; it += NGW) route_item(Q + (size_t)(it >> 3) * 2048 + (it & 7) * 256, k1, k2, ids + (size_t)it * 16, gates + (size_t)it * 16, F.lane);
}

#ifndef MK_GSLOW
#define MK_GSLOW 0
#endif
template <int N> __device__ __forceinline__ float row_ror_add(float v) { return v + __builtin_bit_cast(float, __builtin_amdgcn_update_dpp(0, __builtin_bit_cast(int, v), 0x120 + N, 0xf, 0xf, false)); }
__device__ __forceinline__ float gelu1(float v) {
    const float av = fabsf(v), t = __builtin_amdgcn_rcpf(av * 0.2316418882f + 1.0f);
    float q = t * 0.5307027145f + (-0.7265760135f); q = q * t + 0.7107068705f; q = q * t + (-0.142248368f); q = q * t + 0.127414796f; q = q * t;
    const float e = __builtin_amdgcn_exp2f((v * v) * (-0.72134752044f)); const float m = v * (q * e); return v < 0.f ? m : v - m;
}
__device__ __forceinline__ void gather_phase(Frame& F, int l) {
    const int gw = F.vcu * NWAVES + F.wave, NGW = F.G * NWAVES, lane = F.lane;
    const float* X1 = F.a->out; const float* g = F.a->in[12] + (size_t)l * D; const float* ssqx = wsp<float>(F, WS_SSQX);
    const int* ids = wsp<int>(F, WS_IDS); const float* gates = wsp<float>(F, WS_GATES);
    const unsigned char* U8 = F.ws + WS_UB + l * UB_L; const unsigned char* V8 = F.ws + WS_VB + l * UB_L;
    const int row = lane >> 4;
    const int esel0 = (row == 0) ? 0 : (row == 1) ? 2 : (row == 2) ? 1 : 3;
    for (int t = gw; t < M; t += NGW) {
        float x[16], h[16], acc[16];
        { const float* xp = X1 + (size_t)t * D + 16 * lane; const f32x4 a0 = *(const f32x4*)xp, a1 = *(const f32x4*)(xp + 4), a2 = *(const f32x4*)(xp + 8), a3 = *(const f32x4*)(xp + 12);
#pragma unroll
          for (int e = 0; e < 4; ++e) { x[e] = a0[e]; x[4 + e] = a1[e]; x[8 + e] = a2[e]; x[12 + e] = a3[e]; } }
        float ss = 0.f;
        { const float* sp = ssqx + (size_t)t * 16; const f32x4 a = *(const f32x4*)sp, b = *(const f32x4*)(sp + 4), c = *(const f32x4*)(sp + 8), d = *(const f32x4*)(sp + 12);
          ss = ((a[0] + a[1]) + (a[2] + a[3])) + ((b[0] + b[1]) + (b[2] + b[3])) + ((c[0] + c[1]) + (c[2] + c[3])) + ((d[0] + d[1]) + (d[2] + d[3])); }
        const float rs = (1.0f / 64.0f) / sqrtf(ss * (1.f / D) + EPS);
        { const float* gp = g + 16 * lane; const f32x4 a0 = *(const f32x4*)gp, a1 = *(const f32x4*)(gp + 4), a2 = *(const f32x4*)(gp + 8), a3 = *(const f32x4*)(gp + 12);
#pragma unroll
          for (int e = 0; e < 4; ++e) { h[e] = x[e] * rs * a0[e]; h[4 + e] = x[4 + e] * rs * a1[e]; h[8 + e] = x[8 + e] * rs * a2[e]; h[12 + e] = x[12 + e] * rs * a3[e]; } }
#pragma unroll
        for (int e = 0; e < 16; ++e) acc[e] = 0.f;
        const int* idp = ids + (size_t)t * 128; const float* gtp = gates + (size_t)t * 128;
#pragma unroll 1
        for (int e0 = 0; e0 < 128; e0 += 8) {
            int id[8]; u32x4 uu[8], vv[8];
#pragma unroll
            for (int j = 0; j < 8; ++j) id[j] = __builtin_amdgcn_readfirstlane(idp[e0 + j]);
#pragma unroll
            for (int j = 0; j < 8; ++j) uu[j] = *(const u32x4*)(U8 + (size_t)id[j] * D + 16 * lane);
#pragma unroll
            for (int j = 0; j < 8; ++j) vv[j] = *(const u32x4*)(V8 + (size_t)id[j] * D + 16 * lane);
            const float g0 = gtp[e0 + esel0] * 0.125f, g1 = gtp[e0 + 4 + esel0] * 0.125f;
            float p[8];
#pragma unroll
            for (int j = 0; j < 8; ++j) { float s = 0.f;
#pragma unroll
                for (int w = 0; w < 4; ++w) { const auto lo = __builtin_amdgcn_cvt_pk_f32_fp8((int)uu[j][w], false), hi2 = __builtin_amdgcn_cvt_pk_f32_fp8((int)uu[j][w], true);
                    s = fmaf(h[4 * w], lo[0], s); s = fmaf(h[4 * w + 1], lo[1], s); s = fmaf(h[4 * w + 2], hi2[0], s); s = fmaf(h[4 * w + 3], hi2[1], s); }
                p[j] = s; }
#if MK_GSLOW
            float av[8];
#pragma unroll
            for (int j = 0; j < 8; ++j) av[j] = gelu1(wave_sum(p[j])) * gtp[e0 + j] * 0.125f;
#else
            float q4[4];
#pragma unroll
            for (int j = 0; j < 4; ++j) { auto rr = __builtin_amdgcn_permlane32_swap(__float_as_uint(p[2 * j]), __float_as_uint(p[2 * j + 1]), false, false); q4[j] = __uint_as_float(rr[0]) + __uint_as_float(rr[1]); }
            float t2[2];
#pragma unroll
            for (int j = 0; j < 2; ++j) { auto rr = __builtin_amdgcn_permlane16_swap(__float_as_uint(q4[2 * j]), __float_as_uint(q4[2 * j + 1]), false, false); t2[j] = __uint_as_float(rr[0]) + __uint_as_float(rr[1]); }
#pragma unroll
            for (int j = 0; j < 2; ++j) { t2[j] = row_ror_add<8>(t2[j]); t2[j] = row_ror_add<4>(t2[j]); t2[j] = row_ror_add<2>(t2[j]); t2[j] = row_ror_add<1>(t2[j]); }
            const float a0v = gelu1(t2[0]) * g0, a1v = gelu1(t2[1]) * g1;
            float av[8];
#define RLF(V, L) __builtin_bit_cast(float, __builtin_amdgcn_readlane(__builtin_bit_cast(int, V), L))
            av[0] = RLF(a0v, 0); av[2] = RLF(a0v, 16); av[1] = RLF(a0v, 32); av[3] = RLF(a0v, 48);
            av[4] = RLF(a1v, 0); av[6] = RLF(a1v, 16); av[5] = RLF(a1v, 32); av[7] = RLF(a1v, 48);
#undef RLF
#endif
#pragma unroll
            for (int j = 0; j < 8; ++j)
#pragma unroll
                for (int w = 0; w < 4; ++w) { const auto lo = __builtin_amdgcn_cvt_pk_f32_fp8((int)vv[j][w], false), hi2 = __builtin_amdgcn_cvt_pk_f32_fp8((int)vv[j][w], true);
                    acc[4 * w] = fmaf(av[j], lo[0], acc[4 * w]); acc[4 * w + 1] = fmaf(av[j], lo[1], acc[4 * w + 1]); acc[4 * w + 2] = fmaf(av[j], hi2[0], acc[4 * w + 2]); acc[4 * w + 3] = fmaf(av[j], hi2[1], acc[4 * w + 3]); }
        }
        float s2 = 0.f;
#pragma unroll
        for (int e = 0; e < 16; ++e) { x[e] += acc[e]; s2 += x[e] * x[e]; }
        const float r2 = 1.0f / sqrtf(wave_sum(s2) * (1.f / D) + EPS);
        if (l == 0) {
            float* X2 = wsp<float>(F, WS_X2) + (size_t)t * D + 16 * lane; bf16_t* XN = wsp<bf16_t>(F, WS_XN) + (size_t)t * D + 16 * lane;
#pragma unroll
            for (int w = 0; w < 4; ++w) *(f32x4*)(X2 + 4 * w) = (f32x4){x[4 * w], x[4 * w + 1], x[4 * w + 2], x[4 * w + 3]};
            *(u32x4*)XN = (u32x4){pk2(x[0] * r2, x[1] * r2), pk2(x[2] * r2, x[3] * r2), pk2(x[4] * r2, x[5] * r2), pk2(x[6] * r2, x[7] * r2)};
            *(u32x4*)(XN + 8) = (u32x4){pk2(x[8] * r2, x[9] * r2), pk2(x[10] * r2, x[11] * r2), pk2(x[12] * r2, x[13] * r2), pk2(x[14] * r2, x[15] * r2)};
        } else {
            const float* fg = F.a->in[18] + 16 * lane; float* O = F.a->out + (size_t)t * D + 16 * lane;
#pragma unroll
            for (int w = 0; w < 4; ++w) { const f32x4 gg = *(const f32x4*)(fg + 4 * w); *(f32x4*)(O + 4 * w) = (f32x4){x[4 * w] * r2 * gg[0], x[4 * w + 1] * r2 * gg[1], x[4 * w + 2] * r2 * gg[2], x[4 * w + 3] * r2 * gg[3]}; }
        }
    }
}

#ifndef MK_XCCJ
#define MK_XCCJ 0
#endif
typedef int v2i32_t __attribute__((ext_vector_type(2)));
template <int CTRL> __device__ __forceinline__ float dpp_mov(float v) { return __builtin_bit_cast(float, __builtin_amdgcn_update_dpp(0, __builtin_bit_cast(int, v), CTRL, 0xf, 0xf, false)); }
template <int CTRL> __device__ __forceinline__ float dpp_add(float v) { return v + __builtin_bit_cast(float, __builtin_amdgcn_update_dpp(0, __builtin_bit_cast(int, v), CTRL, 0xf, 0xf, false)); }
__device__ __forceinline__ void gather_u_phase(Frame& F, int l) {
    const bf16_t* X1Bp = wsp<bf16_t>(F, WS_X1B); const float* rsxp = wsp<float>(F, WS_RSX);
    const int lane = F.lane, j = MK_XCCJ ? (int)(xb_xcc_id() & 7u) : (int)(blockIdx.x & 7), wg = (int)(blockIdx.x >> 3), nwg = F.G >> 3, es = lane >> 3, c = lane & 7;
    const float* X1 = F.a->out; const float* ssqx = wsp<float>(F, WS_SSQX); const int* ids = wsp<int>(F, WS_IDS);
    const unsigned char* U8 = F.ws + WS_UB + l * UB_L + (size_t)j * (16384 * 128) + 16 * c; float* PART = wsp<float>(F, WS_PART) + (size_t)j * M * 128;
    float gsl[16];
    { const float* gp = F.a->in[12] + (size_t)l * D + 128 * j + 16 * c;
#pragma unroll
      for (int w = 0; w < 4; ++w) { const f32x4 gg = *(const f32x4*)(gp + 4 * w); gsl[4 * w] = gg[0]; gsl[4 * w + 1] = gg[1]; gsl[4 * w + 2] = gg[2]; gsl[4 * w + 3] = gg[3]; } }
    const int t0 = wg * NWAVES + F.wave, tstep = nwg * NWAVES, ntok = (M - t0 + tstep - 1) / tstep;
#define GU_IDS(dst, tt) do { _Pragma("unroll") for (int w = 0; w < 4; ++w) dst[w] = *(const u32x4*)(ids + (size_t)(tt) * 128 + 16 * es + 4 * w); } while (0)
#define GU_ROWS(dst, idv_) do { _Pragma("unroll") for (int i = 0; i < 16; ++i) dst[i] = *(const u32x4*)(U8 + (size_t)idv_[i >> 2][i & 3] * 128); } while (0)
    u32x4 idn[4], rA[16], rB[16];
    { u32x4 id0[4]; GU_IDS(id0, t0); GU_ROWS(rA, id0); GU_IDS(idn, (ntok > 1 ? t0 + tstep : t0)); }
#define GU_BODY(CUR, NXT, kk) do { const int t = t0 + (kk) * tstep; \
        GU_ROWS(NXT, idn); \
        { const int t2 = ((kk) + 2 < ntok) ? t + 2 * tstep : t; GU_IDS(idn, t2); } \
        f32x2 h2[8];                                                      \
        { const float rs = rsxp[t] * (1.0f / 64.0f); const bf16_t* xp = X1Bp + (size_t)t * D + 128 * j + 16 * c; const u32x4 xa = *(const u32x4*)xp, xb = *(const u32x4*)(xp + 8); \
          _Pragma("unroll") for (int e2 = 0; e2 < 4; ++e2) { h2[e2] = (f32x2){__builtin_bit_cast(float, xa[e2] << 16) * rs * gsl[2 * e2], __builtin_bit_cast(float, xa[e2] & 0xffff0000u) * rs * gsl[2 * e2 + 1]}; \
                                           h2[4 + e2] = (f32x2){__builtin_bit_cast(float, xb[e2] << 16) * rs * gsl[8 + 2 * e2], __builtin_bit_cast(float, xb[e2] & 0xffff0000u) * rs * gsl[8 + 2 * e2 + 1]}; } } \
        float p[16]; \
        _Pragma("unroll") for (int i = 0; i < 16; ++i) { f32x2 s2 = (f32x2){0.f, 0.f}; \
            _Pragma("unroll") for (int w = 0; w < 4; ++w) { const f32x2 lo = __builtin_amdgcn_cvt_pk_f32_fp8((int)CUR[i][w], false), hi2 = __builtin_amdgcn_cvt_pk_f32_fp8((int)CUR[i][w], true); \
                s2 = __builtin_elementwise_fma(h2[2 * w], lo, s2); s2 = __builtin_elementwise_fma(h2[2 * w + 1], hi2, s2); } \
            float s = s2[0] + s2[1]; \
            s = dpp_add<0x141>(s); s = dpp_add<0xB1>(s); s = dpp_add<0x4E>(s); p[i] = s; } \
        if (c == 0) { float* dst = PART + (size_t)t * 128 + 16 * es; \
            _Pragma("unroll") for (int w = 0; w < 4; ++w) *(f32x4*)(dst + 4 * w) = (f32x4){p[4 * w], p[4 * w + 1], p[4 * w + 2], p[4 * w + 3]}; } } while (0)
#pragma unroll 1
    for (int k = 0; k < ntok; k += 2) { GU_BODY(rA, rB, k); if (k + 1 < ntok) GU_BODY(rB, rA, k + 1); }
#undef GU_BODY
#undef GU_IDS
#undef GU_ROWS
}
#ifndef MK_UMFMA
#define MK_UMFMA 1
#endif
#ifndef MK_VMFMA
#define MK_VMFMA 1
#endif
#ifndef MK_VTRDBG
#define MK_VTRDBG 1
#endif
__device__ __forceinline__ void xq_pass(Frame& F, int l) {
    const int gw = F.vcu * NWAVES + F.wave, NGW = F.G * NWAVES, lane = F.lane;
    const bf16_t* X1B = wsp<bf16_t>(F, WS_X1B); const float* ssqx = wsp<float>(F, WS_SSQX); unsigned char* XQ = F.ws + WS_XQ;
    float g[16];
    { const float* gp = F.a->in[12] + (size_t)l * D + 16 * lane;
#pragma unroll
      for (int w = 0; w < 4; ++w) { const f32x4 gg = *(const f32x4*)(gp + 4 * w); g[4 * w] = gg[0] * 8.0f; g[4 * w + 1] = gg[1] * 8.0f; g[4 * w + 2] = gg[2] * 8.0f; g[4 * w + 3] = gg[3] * 8.0f; } }
    for (int m0 = gw; m0 < M; m0 += 4 * NGW) {
        u32x4 xa[4], xb[4]; f32x4 sa[4][4];
#pragma unroll
        for (int q = 0; q < 4; ++q) { const int m = m0 + q * NGW; if (m < M) { const bf16_t* xp = X1B + (size_t)m * D + 16 * lane; xa[q] = *(const u32x4*)xp; xb[q] = *(const u32x4*)(xp + 8);
#pragma unroll
            for (int w = 0; w < 4; ++w) sa[q][w] = *(const f32x4*)(ssqx + (size_t)m * 16 + 4 * w); } }
#pragma unroll
        for (int q = 0; q < 4; ++q) { const int m = m0 + q * NGW; if (m < M) {
            const f32x4 a = sa[q][0], b2 = sa[q][1], c2 = sa[q][2], d2 = sa[q][3];
            const float ss = ((a[0] + a[1]) + (a[2] + a[3])) + ((b2[0] + b2[1]) + (b2[2] + b2[3])) + ((c2[0] + c2[1]) + (c2[2] + c2[3])) + ((d2[0] + d2[1]) + (d2[2] + d2[3]));
            const float rs = 1.0f / sqrtf(ss * (1.f / D) + EPS);
            float h[16];
#pragma unroll
            for (int e2 = 0; e2 < 4; ++e2) { h[2 * e2] = __builtin_bit_cast(float, xa[q][e2] << 16) * rs * g[2 * e2]; h[2 * e2 + 1] = __builtin_bit_cast(float, xa[q][e2] & 0xffff0000u) * rs * g[2 * e2 + 1];
                                             h[8 + 2 * e2] = __builtin_bit_cast(float, xb[q][e2] << 16) * rs * g[8 + 2 * e2]; h[8 + 2 * e2 + 1] = __builtin_bit_cast(float, xb[q][e2] & 0xffff0000u) * rs * g[8 + 2 * e2 + 1]; }
            u32x4 o;
#pragma unroll
            for (int w = 0; w < 4; ++w) { int p = __builtin_amdgcn_cvt_pk_fp8_f32(h[4 * w], h[4 * w + 1], 0, false); p = __builtin_amdgcn_cvt_pk_fp8_f32(h[4 * w + 2], h[4 * w + 3], p, true); o[w] = (unsigned)p; }
            *(u32x4*)(XQ + (size_t)m * 1024 + 16 * lane) = o; } }
    }
}
__device__ __forceinline__ void gather_um_phase(Frame& F, int l) {
    const int lane = F.lane, j = (int)(blockIdx.x & 7), wg = (int)(blockIdx.x >> 3), nwg = F.G >> 3, es = lane >> 3, c8 = lane & 7, m = lane & 15, c = lane >> 4;
    const unsigned short* ids = wsp<unsigned short>(F, WS_IDS);
    const unsigned char* U8 = F.ws + WS_UB + l * UB_L + (size_t)j * (16384 * 128) + 16 * c8; const unsigned char* XQ = F.ws + WS_XQ + 128 * j + 8 * c;
    bf16_t* PARTB = wsp<bf16_t>(F, WS_PART) + (size_t)j * M * 128;
    LAS unsigned char* img = F.lds + F.wave * 16384;
    LAS unsigned char* wr0 = img + es * 128 + ((c8 ^ (es >> 1)) << 4), * wr1 = img + es * 128 + ((c8 ^ ((es >> 1) | 4)) << 4);
    const int msw = (m >> 1) & 7; const LAS unsigned char* rd = img + m * 128 + (c & 1) * 8;
    const int t0 = wg * NWAVES + F.wave, tstep = nwg * NWAVES, ntok = (M - t0 + tstep - 1) / tstep;
#define GM_IDS(dst, tt) do { const unsigned short* ip_ = ids + (size_t)(tt) * 128 + 8 * es; dst[0] = *(const u32x4*)ip_; dst[1] = *(const u32x4*)(ip_ + 64); } while (0)
#define GM_ROWS(dst, idv_) do { _Pragma("unroll") for (int i = 0; i < 16; ++i) dst[i] = *(const u32x4*)(U8 + (size_t)(((i >> 1) & 1) ? (idv_[i & 1][i >> 2] >> 16) : (idv_[i & 1][i >> 2] & 0xffffu)) * 128); } while (0)
#define GM_X(dst, tt) do { _Pragma("unroll") for (int s_ = 0; s_ < 4; ++s_) dst[s_] = *(const u32x2*)(XQ + (size_t)(tt) * 1024 + 32 * s_); } while (0)
#define GM_PK(v_) ((long)(((unsigned long long)(v_)[1] << 32) | (unsigned long long)(v_)[0]))
    u32x4 idn[2], rA[16], rB[16]; u32x2 xA[4], xB[4];
    { u32x4 id0[2]; GM_IDS(id0, t0); GM_ROWS(rA, id0); GM_X(xA, t0); GM_IDS(idn, (ntok > 1 ? t0 + tstep : t0)); }
#define GM_BODY(CUR, NXT, XC, XNX, kk) do { const int t = t0 + (kk) * tstep; \
        GM_ROWS(NXT, idn); GM_X(XNX, (((kk) + 1 < ntok) ? t + tstep : t)); \
        { const int t2 = ((kk) + 2 < ntok) ? t + 2 * tstep : t; GM_IDS(idn, t2); } \
        _Pragma("unroll") for (int i = 0; i < 16; ++i) *(LAS u32x4*)(((i & 1) ? wr1 : wr0) + 1024 * i) = CUR[i]; \
        f32x4 d[8]; \
        _Pragma("unroll") for (int g = 0; g < 8; ++g) { f32x4 a_ = (f32x4){0.f, 0.f, 0.f, 0.f}; \
            _Pragma("unroll") for (int s_ = 0; s_ < 4; ++s_) { const u32x2 av_ = *(const LAS u32x2*)(rd + 2048 * g + (((2 * s_ + (c >> 1)) ^ msw) << 4)); \
                a_ = __builtin_amdgcn_mfma_f32_16x16x32_fp8_fp8(GM_PK(av_), GM_PK(XC[s_]), a_, 0, 0, 0); } \
            d[g] = a_; } \
        if (m == 0) { bf16_t* dst = PARTB + (size_t)t * 128 + 32 * c; const float SC = 1.0f / 512.0f; \
            _Pragma("unroll") for (int i = 0; i < 4; ++i) *(u32x4*)(dst + 8 * i) = (u32x4){cvt_pk(d[0][i] * SC, d[1][i] * SC), cvt_pk(d[2][i] * SC, d[3][i] * SC), cvt_pk(d[4][i] * SC, d[5][i] * SC), cvt_pk(d[6][i] * SC, d[7][i] * SC)}; } } while (0)
#pragma unroll 1
    for (int k = 0; k < ntok; k += 2) { GM_BODY(rA, rB, xA, xB, k); if (k + 1 < ntok) GM_BODY(rB, rA, xB, xA, k + 1); }
#undef GM_BODY
#undef GM_IDS
#undef GM_ROWS
#undef GM_X
#undef GM_PK
}
__device__ __forceinline__ void gather_vm_phase(Frame& F, int l) {
    const int lane = F.lane, j = (int)(blockIdx.x & 7), wg = (int)(blockIdx.x >> 3), nwg = F.G >> 3, es = lane >> 3, c8 = lane & 7, n = lane & 15, c = lane >> 4;
    const unsigned short* ids = wsp<unsigned short>(F, WS_IDS); const unsigned char* AHL = F.ws + ((n & 1) ? WS_AL : WS_AH) + 8 * c;
    const unsigned char* V8 = F.ws + WS_VB + l * UB_L + (size_t)j * (16384 * 128) + 16 * c8;
    const int dwi = (n & 1) ? 16 * c + 8 + (n >> 1) : 16 * c + (n >> 1);
    const bf16_t* X1B = wsp<bf16_t>(F, WS_X1B) + 128 * j + 2 * dwi; bf16_t* XN = wsp<bf16_t>(F, WS_XN) + 128 * j + 2 * dwi; float* SSQ2 = wsp<float>(F, WS_SSQ2);
    LAS unsigned char* img = F.lds + F.wave * 16384;
    LAS unsigned char* wr = img + es * 2048;
    const int r = n >> 1, rsw = ((c & 1) << 2) | (r >> 1); const LAS unsigned char* rd = img + (8 * c + r) * 128 + 8 * (n & 1);
    const int t0 = wg * NWAVES + F.wave, tstep = nwg * NWAVES, ntok = (M - t0 + tstep - 1) / tstep;
#define VM_IDS(dst, tt) do { _Pragma("unroll") for (int w = 0; w < 2; ++w) dst[w] = *(const u32x4*)(ids + (size_t)(tt) * 128 + 16 * es + 8 * w); } while (0)
#define VM_ROWS(dst, idv_) do { _Pragma("unroll") for (int i = 0; i < 16; ++i) dst[i] = *(const u32x4*)(V8 + (size_t)((i & 1) ? (idv_[i >> 3][(i >> 1) & 3] >> 16) : (idv_[i >> 3][(i >> 1) & 3] & 0xffffu)) * 128); } while (0)
#define VM_A(dh, tt) do { _Pragma("unroll") for (int s_ = 0; s_ < 4; ++s_) dh[s_] = *(const u32x2*)(AHL + (size_t)(tt) * 128 + 32 * s_); } while (0)
#define VM_PK(v_) ((long)(((unsigned long long)(v_)[1] << 32) | (unsigned long long)(v_)[0]))
    u32x4 idn[2], rA[16], rB[16]; u32x2 hA[4], hB[4];
    { u32x4 id0[2]; VM_IDS(id0, t0); VM_ROWS(rA, id0); VM_A(hA, t0); VM_IDS(idn, (ntok > 1 ? t0 + tstep : t0)); }
#define VM_BODY(CUR, NXT, HC, HN, kk) do { const int t = t0 + (kk) * tstep; \
        VM_ROWS(NXT, idn); VM_A(HN, (((kk) + 1 < ntok) ? t + tstep : t)); \
        { const int t2 = ((kk) + 2 < ntok) ? t + 2 * tstep : t; VM_IDS(idn, t2); } \
        const unsigned x1w = *(const unsigned*)(X1B + (size_t)t * D); \
        _Pragma("unroll") for (int i = 0; i < 16; ++i) *(LAS u32x4*)(wr + 128 * i + ((c8 ^ ((i >> 1) & 7)) << 4)) = CUR[i]; \
        float d[8]; \
        _Pragma("unroll") for (int b_ = 0; b_ < 8; ++b_) { f32x4 a_ = (f32x4){0.f, 0.f, 0.f, 0.f}; \
            _Pragma("unroll") for (int s_ = 0; s_ < 4; ++s_) { const v2i32_t bv_ = __builtin_amdgcn_ds_read_tr8_b64_v2i32((LAS v2i32_t*)(rd + 4096 * s_ + ((b_ ^ rsw) << 4))); \
                a_ = __builtin_amdgcn_mfma_f32_16x16x32_fp8_fp8(VM_PK(HC[s_]), __builtin_bit_cast(long, bv_), a_, 0, 0, 0); } \
            d[b_] = a_[0] + a_[1]; } \
        const float vA = c == 0 ? d[0] : (c == 1 ? d[2] : (c == 2 ? d[4] : d[6])), vB = c == 0 ? d[1] : (c == 1 ? d[3] : (c == 2 ? d[5] : d[7])); \
        const float sA = dpp_mov<0xB1>(vA), sB = dpp_mov<0xB1>(vB); \
        const float SCV = 1.0f / 256.0f;     \
        const float o0 = ((n & 1) ? sB : vA) * SCV + __builtin_bit_cast(float, x1w << 16), o1 = ((n & 1) ? vB : sA) * SCV + __builtin_bit_cast(float, x1w & 0xffff0000u); \
        *(unsigned*)(XN + (size_t)t * D) = cvt_pk(o0, o1); \
        float sq = o0 * o0 + o1 * o1; sq = wave_sum(sq); \
        if (lane == 0) SSQ2[(size_t)t * 8 + j] = sq; } while (0)
#pragma unroll 1
    for (int k = 0; k < ntok; k += 2) { VM_BODY(rA, rB, hA, hB, k); if (k + 1 < ntok) VM_BODY(rB, rA, hB, hA, k + 1); }
#undef VM_BODY
#undef VM_IDS
#undef VM_ROWS
#undef VM_A
#undef VM_PK
}
__device__ __forceinline__ void gather_ux_phase(Frame& F, int l) {
    const int lane = F.lane, j = (int)(blockIdx.x & 7), wg = (int)(blockIdx.x >> 3), nwg = F.G >> 3, row = lane >> 4;
    const bf16_t* X1B = wsp<bf16_t>(F, WS_X1B); const float* ssqx = wsp<float>(F, WS_SSQX); const int* ids = wsp<int>(F, WS_IDS); float* gates = wsp<float>(F, WS_GATES);
    const unsigned char* U8 = F.ws + WS_UB + l * UB_L + 16 * lane;
    float gl[16];
    { const float* gp = F.a->in[12] + (size_t)l * D + 16 * lane;
#pragma unroll
      for (int w = 0; w < 4; ++w) { const f32x4 gg = *(const f32x4*)(gp + 4 * w); gl[4 * w] = gg[0]; gl[4 * w + 1] = gg[1]; gl[4 * w + 2] = gg[2]; gl[4 * w + 3] = gg[3]; } }
    const float* rsx = wsp<float>(F, WS_RSX);
    const int t0 = wg * NWAVES + F.wave, tstep = nwg * NWAVES, ntok = (M - t0 + tstep - 1) / tstep;
    int id0 = ids[(size_t)t0 * 128 + lane], id1 = ids[(size_t)t0 * 128 + 64 + lane];
    float gt0 = gates[(size_t)t0 * 128 + lane], gt1 = gates[(size_t)t0 * 128 + 64 + lane];
    u32x4 xa = *(const u32x4*)(X1B + (size_t)t0 * D + 16 * lane), xb = *(const u32x4*)(X1B + (size_t)t0 * D + 16 * lane + 8);
    float rsv = rsx[t0];
#pragma unroll 1
    for (int k = 0; k < ntok; ++k) {
        const int t = t0 + k * tstep, tn = (k + 1 < ntok) ? t + tstep : t;
        const int nid0 = ids[(size_t)tn * 128 + lane], nid1 = ids[(size_t)tn * 128 + 64 + lane];
        const float ngt0 = gates[(size_t)tn * 128 + lane], ngt1 = gates[(size_t)tn * 128 + 64 + lane];
        const u32x4 nxa = *(const u32x4*)(X1B + (size_t)tn * D + 16 * lane), nxb = *(const u32x4*)(X1B + (size_t)tn * D + 16 * lane + 8);
        const float nrs = rsx[tn];
        unsigned long long m0 = __ballot((id0 >> 11) == j), m1 = __ballot((id1 >> 11) == j);
        float h[16];
        { const float rs = rsv * (1.0f / 64.0f);
#pragma unroll
          for (int e2 = 0; e2 < 4; ++e2) { h[2 * e2] = __builtin_bit_cast(float, xa[e2] << 16) * rs * gl[2 * e2]; h[2 * e2 + 1] = __builtin_bit_cast(float, xa[e2] & 0xffff0000u) * rs * gl[2 * e2 + 1];
                                           h[8 + 2 * e2] = __builtin_bit_cast(float, xb[e2] << 16) * rs * gl[8 + 2 * e2]; h[8 + 2 * e2 + 1] = __builtin_bit_cast(float, xb[e2] & 0xffff0000u) * rs * gl[8 + 2 * e2 + 1]; } }
        while (m0 | m1) {
            int sl[16], idk[16]; float gk[16]; int lastid = 2048 * j;
#pragma unroll
            for (int q = 0; q < 16; ++q) {
                if (m0) { const int s2 = __builtin_ctzll(m0); m0 &= m0 - 1; sl[q] = s2; idk[q] = __builtin_amdgcn_readlane(id0, s2); gk[q] = __builtin_bit_cast(float, __builtin_amdgcn_readlane(__builtin_bit_cast(int, gt0), s2)); lastid = idk[q]; }
                else if (m1) { const int s2 = __builtin_ctzll(m1); m1 &= m1 - 1; sl[q] = 64 + s2; idk[q] = __builtin_amdgcn_readlane(id1, s2); gk[q] = __builtin_bit_cast(float, __builtin_amdgcn_readlane(__builtin_bit_cast(int, gt1), s2)); lastid = idk[q]; }
                else { sl[q] = -1; idk[q] = lastid; gk[q] = 0.f; } }
            u32x4 rw[16];
#pragma unroll
            for (int q = 0; q < 16; ++q) rw[q] = *(const u32x4*)(U8 + (size_t)idk[q] * D);
#pragma unroll
            for (int gq = 0; gq < 2; ++gq) {
                if (sl[8 * gq] < 0) break;
                float p[8];
#pragma unroll
                for (int q = 0; q < 8; ++q) { float s = 0.f;
#pragma unroll
                    for (int w = 0; w < 4; ++w) { const auto lo = __builtin_amdgcn_cvt_pk_f32_fp8((int)rw[8 * gq + q][w], false), hi2 = __builtin_amdgcn_cvt_pk_f32_fp8((int)rw[8 * gq + q][w], true);
                        s = fmaf(h[4 * w], lo[0], s); s = fmaf(h[4 * w + 1], lo[1], s); s = fmaf(h[4 * w + 2], hi2[0], s); s = fmaf(h[4 * w + 3], hi2[1], s); }
                    p[q] = s; }
                float q4[4];
#pragma unroll
                for (int q = 0; q < 4; ++q) { auto rr = __builtin_amdgcn_permlane32_swap(__float_as_uint(p[2 * q]), __float_as_uint(p[2 * q + 1]), false, false); q4[q] = __uint_as_float(rr[0]) + __uint_as_float(rr[1]); }
                float t2[2];
#pragma unroll
                for (int q = 0; q < 2; ++q) { auto rr = __builtin_amdgcn_permlane16_swap(__float_as_uint(q4[2 * q]), __float_as_uint(q4[2 * q + 1]), false, false); t2[q] = __uint_as_float(rr[0]) + __uint_as_float(rr[1]); }
#pragma unroll
                for (int q = 0; q < 2; ++q) { t2[q] = row_ror_add<8>(t2[q]); t2[q] = row_ror_add<4>(t2[q]); t2[q] = row_ror_add<2>(t2[q]); t2[q] = row_ror_add<1>(t2[q]); }
                const int b8 = 8 * gq;
                const int sA = (row == 0) ? sl[b8 + 0] : (row == 1) ? sl[b8 + 2] : (row == 2) ? sl[b8 + 1] : sl[b8 + 3], sB = (row == 0) ? sl[b8 + 4] : (row == 1) ? sl[b8 + 6] : (row == 2) ? sl[b8 + 5] : sl[b8 + 7];
                const float gA = (row == 0) ? gk[b8 + 0] : (row == 1) ? gk[b8 + 2] : (row == 2) ? gk[b8 + 1] : gk[b8 + 3], gB = (row == 0) ? gk[b8 + 4] : (row == 1) ? gk[b8 + 6] : (row == 2) ? gk[b8 + 5] : gk[b8 + 7];
                if ((lane & 15) == 0) { if (sA >= 0) gates[(size_t)t * 128 + sA] = gelu1(t2[0]) * gA * 0.125f; if (sB >= 0) gates[(size_t)t * 128 + sB] = gelu1(t2[1]) * gB * 0.125f; }
            }
        }
        id0 = nid0; id1 = nid1; gt0 = ngt0; gt1 = ngt1; xa = nxa; xb = nxb; rsv = nrs;
    }
}
__device__ __forceinline__ void gather_r_phase_f32(Frame& F) {
    const int gt = (int)blockIdx.x * (NWAVES * 64) + F.tid, NT = F.G * NWAVES * 64; const float* PART = wsp<float>(F, WS_PART); float* gates = wsp<float>(F, WS_GATES);
    for (int i = gt; i < M * 32; i += NT) { f32x4 s = *(const f32x4*)(PART + (size_t)i * 4);
#pragma unroll
        for (int jj = 1; jj < 8; ++jj) s = s + *(const f32x4*)(PART + (size_t)jj * M * 128 + (size_t)i * 4);
        const f32x4 g = *(const f32x4*)(gates + (size_t)i * 4);
        *(f32x4*)(gates + (size_t)i * 4) = (f32x4){gelu1(s[0]) * g[0] * 0.125f, gelu1(s[1]) * g[1] * 0.125f, gelu1(s[2]) * g[2] * 0.125f, gelu1(s[3]) * g[3] * 0.125f}; }
}
__device__ __forceinline__ void gather_r_phase(Frame& F) {
    if (!MK_UMFMA) { gather_r_phase_f32(F); return; }
    const int gt = (int)blockIdx.x * (NWAVES * 64) + F.tid, NT = F.G * NWAVES * 64; const bf16_t* PARTB = wsp<bf16_t>(F, WS_PART); float* gates = wsp<float>(F, WS_GATES);
    for (int i = gt; i < M * 16; i += NT) { float s[8];
#pragma unroll
        for (int k = 0; k < 8; ++k) s[k] = 0.f;
#pragma unroll
        for (int jj = 0; jj < 8; ++jj) { const u32x4 v = *(const u32x4*)(PARTB + (size_t)jj * M * 128 + (size_t)i * 8);
#pragma unroll
            for (int e2 = 0; e2 < 4; ++e2) { s[2 * e2] += __builtin_bit_cast(float, v[e2] << 16); s[2 * e2 + 1] += __builtin_bit_cast(float, v[e2] & 0xffff0000u); } }
        const f32x4 g0 = *(const f32x4*)(gates + (size_t)i * 8), g1 = *(const f32x4*)(gates + (size_t)i * 8 + 4);
        if (!MK_VMFMA) {
        *(u32x4*)(wsp<bf16_t>(F, WS_AVB) + (size_t)i * 8) = (u32x4){cvt_pk(gelu1(s[0]) * g0[0] * 0.125f, gelu1(s[1]) * g0[1] * 0.125f), cvt_pk(gelu1(s[2]) * g0[2] * 0.125f, gelu1(s[3]) * g0[3] * 0.125f),
                                                                   cvt_pk(gelu1(s[4]) * g1[0] * 0.125f, gelu1(s[5]) * g1[1] * 0.125f), cvt_pk(gelu1(s[6]) * g1[2] * 0.125f, gelu1(s[7]) * g1[3] * 0.125f)};
        } else {
            float av_[8];
#pragma unroll
            for (int k = 0; k < 8; ++k) av_[k] = gelu1(s[k]) * (k < 4 ? g0[k & 3] : g1[k & 3]) * 32.0f;
            u32x2 hi_, lo_;
#pragma unroll
            for (int w = 0; w < 2; ++w) { int p = __builtin_amdgcn_cvt_pk_fp8_f32(av_[4 * w], av_[4 * w + 1], 0, false); p = __builtin_amdgcn_cvt_pk_fp8_f32(av_[4 * w + 2], av_[4 * w + 3], p, true);
                const f32x2 b0 = __builtin_amdgcn_cvt_pk_f32_fp8(p, false), b1 = __builtin_amdgcn_cvt_pk_f32_fp8(p, true);
                int q = __builtin_amdgcn_cvt_pk_fp8_f32(av_[4 * w] - b0[0], av_[4 * w + 1] - b0[1], 0, false); q = __builtin_amdgcn_cvt_pk_fp8_f32(av_[4 * w + 2] - b1[0], av_[4 * w + 3] - b1[1], q, true);
                hi_[w] = (unsigned)p; lo_[w] = (unsigned)q; }
            *(u32x2*)(F.ws + WS_AH + (size_t)i * 8) = hi_; *(u32x2*)(F.ws + WS_AL + (size_t)i * 8) = lo_; } }
}
__device__ __forceinline__ void gather_v_phase(Frame& F, int l) {
    const int lane = F.lane, j = MK_XCCJ ? (int)(xb_xcc_id() & 7u) : (int)(blockIdx.x & 7), wg = (int)(blockIdx.x >> 3), nwg = F.G >> 3, es = lane >> 3, c = lane & 7, row = lane >> 4;
    const bf16_t* X1B = wsp<bf16_t>(F, WS_X1B); const unsigned short* ids = wsp<unsigned short>(F, WS_IDS); const bf16_t* AV = wsp<bf16_t>(F, WS_AVB);
    const unsigned char* V8 = F.ws + WS_VB + l * UB_L + (size_t)j * (16384 * 128) + 16 * c; float* X2 = wsp<float>(F, WS_X2); bf16_t* XN = wsp<bf16_t>(F, WS_XN); float* SSQ2 = wsp<float>(F, WS_SSQ2);
    const int t0 = wg * NWAVES + F.wave, tstep = nwg * NWAVES, ntok = (M - t0 + tstep - 1) / tstep;
#define GV_IDS(dst, tt) do { _Pragma("unroll") for (int w = 0; w < 2; ++w) dst[w] = *(const u32x4*)(ids + (size_t)(tt) * 128 + 16 * es + 8 * w); } while (0)
#define GV_ROWS(dst, idv_) do { _Pragma("unroll") for (int i = 0; i < 16; ++i) dst[i] = *(const u32x4*)(V8 + (size_t)((i & 1) ? (idv_[i >> 3][(i >> 1) & 3] >> 16) : (idv_[i >> 3][(i >> 1) & 3] & 0xffffu)) * 128); } while (0)
    u32x4 idn[2], rA[16], rB[16];
    { u32x4 id0[2]; GV_IDS(id0, t0); GV_ROWS(rA, id0); GV_IDS(idn, (ntok > 1 ? t0 + tstep : t0)); }
#define GV_BODY(CUR, NXT, kk) do { const int t = t0 + (kk) * tstep; \
        GV_ROWS(NXT, idn); \
        { const int t2 = ((kk) + 2 < ntok) ? t + 2 * tstep : t; GV_IDS(idn, t2); } \
        u32x4 av[2]; \
        _Pragma("unroll") for (int w = 0; w < 2; ++w) av[w] = *(const u32x4*)(AV + (size_t)t * 128 + 16 * es + 8 * w); \
        const u32x2 x1b_ = *(const u32x2*)(X1B + (size_t)t * D + 128 * j + 16 * c + 4 * row); \
        const f32x4 x1v = (f32x4){__builtin_bit_cast(float, x1b_.x << 16), __builtin_bit_cast(float, x1b_.x & 0xffff0000u), __builtin_bit_cast(float, x1b_.y << 16), __builtin_bit_cast(float, x1b_.y & 0xffff0000u)}; \
        f32x2 acc2[8];                                                    \
        _Pragma("unroll") for (int e2 = 0; e2 < 8; ++e2) acc2[e2] = (f32x2){0.f, 0.f}; \
        _Pragma("unroll") for (int i = 0; i < 16; ++i) { const unsigned aw_ = av[i >> 3][(i >> 1) & 3]; const float a = __builtin_bit_cast(float, (i & 1) ? (aw_ & 0xffff0000u) : (aw_ << 16)); const f32x2 a2 = (f32x2){a, a}; \
            _Pragma("unroll") for (int w = 0; w < 4; ++w) { const f32x2 lo = __builtin_amdgcn_cvt_pk_f32_fp8((int)CUR[i][w], false), hi2 = __builtin_amdgcn_cvt_pk_f32_fp8((int)CUR[i][w], true); \
                acc2[2 * w] = __builtin_elementwise_fma(a2, lo, acc2[2 * w]); acc2[2 * w + 1] = __builtin_elementwise_fma(a2, hi2, acc2[2 * w + 1]); } } \
        float acc[16]; \
        _Pragma("unroll") for (int e2 = 0; e2 < 8; ++e2) { acc[2 * e2] = acc2[e2][0]; acc[2 * e2 + 1] = acc2[e2][1]; } \
        float v8[8]; \
        _Pragma("unroll") for (int m = 0; m < 8; ++m) { auto rr = __builtin_amdgcn_permlane32_swap(__float_as_uint(acc[m]), __float_as_uint(acc[m + 8]), false, false); v8[m] = __uint_as_float(rr[0]) + __uint_as_float(rr[1]); } \
        float v4[4]; \
        _Pragma("unroll") for (int m = 0; m < 4; ++m) { auto rr = __builtin_amdgcn_permlane16_swap(__float_as_uint(v8[m]), __float_as_uint(v8[m + 4]), false, false); v4[m] = __uint_as_float(rr[0]) + __uint_as_float(rr[1]); } \
        _Pragma("unroll") for (int m = 0; m < 4; ++m) v4[m] = row_ror_add<8>(v4[m]); \
        const f32x4 x2v = (f32x4){x1v[0] + v4[0], x1v[1] + v4[1], x1v[2] + v4[2], x1v[3] + v4[3]}; \
        float sq = 0.f; \
        if ((lane & 8) == 0) { const size_t off = (size_t)t * D + 128 * j + 16 * c + 4 * row; \
            u32x2 w2; w2.x = cvt_pk(x2v[0], x2v[1]); w2.y = cvt_pk(x2v[2], x2v[3]); *(u32x2*)(XN + off) = w2; \
            sq = (x2v[0] * x2v[0] + x2v[1] * x2v[1]) + (x2v[2] * x2v[2] + x2v[3] * x2v[3]); } \
        sq = wave_sum(sq); \
        if (lane == 0) SSQ2[(size_t)t * 8 + j] = sq; } while (0)
#pragma unroll 1
    for (int k = 0; k < ntok; k += 2) { GV_BODY(rA, rB, k); if (k + 1 < ntok) GV_BODY(rB, rA, k + 1); }
#undef GV_BODY
#undef GV_IDS
#undef GV_ROWS
}
__device__ __forceinline__ void final_phase(Frame& F) {
    const int gw = F.vcu * NWAVES + F.wave, NGW = F.G * NWAVES, lane = F.lane; const bf16_t* XN = wsp<bf16_t>(F, WS_XN); const float* SSQ2 = wsp<float>(F, WS_SSQ2); const float* fg = F.a->in[18]; float* O = F.a->out;
    f32x4 gg[4];
#pragma unroll
    for (int w = 0; w < 4; ++w) gg[w] = *(const f32x4*)(fg + 256 * w + 4 * lane);
    for (int t0 = gw; t0 < M; t0 += 8 * NGW) {
        u32x2 xv[8][4]; f32x4 sa[8], sb[8];
#pragma unroll
        for (int k = 0; k < 8; ++k) { const int t = t0 + k * NGW; if (t < M) { sa[k] = *(const f32x4*)(SSQ2 + (size_t)t * 8); sb[k] = *(const f32x4*)(SSQ2 + (size_t)t * 8 + 4);
#pragma unroll
            for (int w = 0; w < 4; ++w) xv[k][w] = *(const u32x2*)(XN + (size_t)t * D + 256 * w + 4 * lane); } }
#pragma unroll
        for (int k = 0; k < 8; ++k) { const int t = t0 + k * NGW; if (t < M) { const f32x4 a = sa[k], b = sb[k];
            const float r2 = 1.0f / sqrtf((((a[0] + a[1]) + (a[2] + a[3])) + ((b[0] + b[1]) + (b[2] + b[3]))) * (1.f / D) + EPS);
#pragma unroll
            for (int w = 0; w < 4; ++w) { const u32x2 v = xv[k][w]; const float x0 = __builtin_bit_cast(float, v.x << 16), x1 = __builtin_bit_cast(float, v.x & 0xffff0000u), x2 = __builtin_bit_cast(float, v.y << 16), x3 = __builtin_bit_cast(float, v.y & 0xffff0000u);
                *(f32x4*)(O + (size_t)t * D + 256 * w + 4 * lane) = (f32x4){x0 * r2 * gg[w][0], x1 * r2 * gg[w][1], x2 * r2 * gg[w][2], x3 * r2 * gg[w][3]}; } } }
    }
}
}

namespace fx {
#ifndef MK_GSLICE
#define MK_GSLICE 1
#endif
constexpr int PPL = MK_GSLICE ? (MK_UEXP ? 7 : 8) : 6;
constexpr int N_PHASES = 2 + 2 * PPL - (MK_GSLICE ? 0 : 1);
#ifndef MK_DBGQ
#define MK_DBGQ 0
#endif
#ifndef MK_MASK
#define MK_MASK 255
#endif
#ifndef PG8_SP2
#define PG8_SP2 true
#endif
#ifndef PG8_ALIGN
#define PG8_ALIGN true
#endif

typedef const __attribute__((address_space(4))) Args* ArgsK;
__device__ __forceinline__ void make_frame(Frame& F, unsigned char* lds) {
    ArgsK kp = (ArgsK)__builtin_amdgcn_kernarg_segment_ptr(); asm volatile("" : "+s"(kp));
    int tid = threadIdx.x; asm volatile("" : "+v"(tid));
    F.lds = (LAS unsigned char*)lds; F.MISC = (volatile LAS unsigned*)(F.lds + MISC_OFF);
    F.tid = tid; F.lane = tid & 63; F.wave = __builtin_amdgcn_readfirstlane(tid >> 6);
    F.G = gridDim.x; { const int bx = blockIdx.x; F.vcu = (F.G % 8 == 0) ? (bx % 8) * (F.G / 8) + bx / 8 : bx; }
    F.a = kp; F.ws = kp->ws; F.ctl = (gu32*)(F.ws + WS_CTL);
}
template <int ph> __device__ __forceinline__ void run_phase(unsigned char* lds) {
    Frame F; make_frame(F, lds);
    ArgsK A = F.a;
    if (ph == 0) { if (MK_MASK & 128) p0_prologue(F, A->pad & 15); return; }
    if (MK_GSLICE && ph == N_PHASES - 1) { final_phase(F); return; }
    constexpr int l = (ph - 1) / PPL, s = (ph - 1) % PPL;
    if (s == 0 && (MK_MASK & 1)) {
        pg8::Gemm g{wsp<bf16_t>(F, WS_XN), wsp<bf16_t>(F, WS_WIN + l * WIN_L), M, NP, D, D, D}; pg8::StaticOrder S; S.init(M, NP, F.G, (int)blockIdx.x);
        EpiG1 E{wsp<bf16_t>(F, WS_PROJ), wsp<float>(F, WS_FLOG), wsp<float>(F, WS_SSQQ), wsp<float>(F, WS_SSQKV), wsp<float>(F, WS_SSQ2)};
        pg8::gemm_phase<EpiG1, pg8::StaticOrder, PG8_ALIGN, PG8_SP2>(F.lds, g, S, E);
        if (MK_CONVQ && l == 0) {
            pg8::Unit u3; if (!S.next(2, u3)) {
#pragma unroll 1
                for (int k = 0; k < 2; ++k) { const unsigned tk = attn_pop(F, 6); if (tk < 512u) conv_unit(F, 511 - (int)tk); } } }
    } else if (s == 1 && (MK_MASK & 2)) {
        if (!(MK_MASK & 256)) prep_phase(F, l);
        int kmla = 384; asm volatile("" : "+s"(kmla));
        pg8::Gemm g{wsp<bf16_t>(F, WS_PROJ) + PC_CQ, wsp<bf16_t>(F, WS_WMLA + l * WMLA_L), M, 1024, kmla, NP, 384}; pg8::StaticOrder S; S.init(M, 1024, F.G, (int)blockIdx.x);
        const float* ct = wsp<float>(F, WS_ROPE);
        LAS float* fac = (LAS float*)(F.lds + FAC_OFF);
        EpiMla E{wsp<bf16_t>(F, WS_QUP), wsp<bf16_t>(F, WS_KVUP), wsp<float>(F, WS_SSQQ), wsp<float>(F, WS_SSQKV), ct, ct + 2048 * 16, (const LAS float*)fac};
        { pg8::Unit u; if (S.next(0, u)) E.rs_prelude(u, F.tid, fac); }
        __syncthreads();
        pg8::gemm_phase<EpiMla, pg8::StaticOrder, PG8_ALIGN, PG8_SP2>(F.lds, g, S, E);
    } else if (s == 2 && (MK_MASK & 4)) {
        attn_phase(F, l);
    } else if (s == 3 && (MK_MASK & 8)) {
        pg8::Gemm g{wsp<bf16_t>(F, WS_Y), wsp<bf16_t>(F, WS_WOUT + l * WOUT_L), M, D, D, D, D}; pg8::StaticOrder S; S.init(M, D, F.G, (int)blockIdx.x);
        pg8::Unit u; LAS float* fac = (LAS float*)(F.lds + FAC_OFF);
        if (S.next(0, u) && F.tid < 256) { const int row = u.pm * 256 + F.tid; const float* sp = wsp<float>(F, WS_SSQH) + (size_t)row * 16;
            const float s1 = ((sp[0] + sp[1]) + (sp[2] + sp[3])) + (sp[4] + sp[5]), s2 = (sp[6] + sp[7]) + (sp[8] + sp[9]), s3 = ((sp[10] + sp[11]) + (sp[12] + sp[13])) + (sp[14] + sp[15]);
            const float r1 = 1.0f / sqrtf(s1 * (1.f / 384.f) + EPS), r2 = 1.0f / sqrtf(s2 * (1.f / 256.f) + EPS), r3 = 1.0f / sqrtf(s3 * (1.f / 384.f) + EPS);
            fac[F.tid] = r1 / r2; fac[256 + F.tid] = r2 / r3; fac[512 + F.tid] = r3; }
        __syncthreads();
        EpiWout E{(const LAS float*)fac, wsp<bf16_t>(F, WS_XN), wsp<bf16_t>(F, WS_X1B), wsp<float>(F, WS_SSQX)};
        pg8::gemm_phase<EpiWout, pg8::StaticOrder, false, PG8_SP2>(F.lds, g, S, E);
    } else if (s == 4 && (MK_MASK & 16)) {
        if (MK_UMFMA) xq_pass(F, l);
        pg8::Gemm g{wsp<bf16_t>(F, WS_X1B), wsp<bf16_t>(F, WS_WQ + l * WQ_L), M, 2048, D, D, D};
        LAS float* fac = (LAS float*)(F.lds + FAC_OFF);
        EpiQ E{wsp<float>(F, WS_SSQX), wsp<bf16_t>(F, WS_KEYS) + (size_t)l * 65536, wsp<unsigned short>(F, WS_IDS), wsp<float>(F, WS_GATES), (MK_DBGQ ? wsp<float>(F, WS_QF) : nullptr), wsp<float>(F, WS_RSX), (const LAS float*)fac};
#pragma unroll 1
        for (int r = 0; r < 2; ++r) { OneUnit S; S.S.init(M, 2048, F.G, (int)blockIdx.x); S.i = r;
            pg8::Unit u; if (S.S.next(r, u)) E.rs_prelude(u, F.tid, fac);
            __syncthreads();
            pg8::gemm_phase<EpiQ, OneUnit, false, PG8_SP2>(F.lds, g, S, E); }
    } else if (MK_GSLICE && MK_UEXP && s == 5) { gather_ux_phase(F, l);
    } else if (MK_GSLICE && MK_UEXP && s == 6) { gather_v_phase(F, l);
    } else if (MK_GSLICE && !MK_UEXP && s == 5) { if (MK_UMFMA) gather_um_phase(F, l); else gather_u_phase(F, l);
    } else if (MK_GSLICE && !MK_UEXP && s == 6) { gather_r_phase(F);
    } else if (MK_GSLICE && !MK_UEXP && s == 7) { if (MK_VMFMA) gather_vm_phase(F, l); else gather_v_phase(F, l);
    } else if (!MK_GSLICE && s == 5 && (MK_MASK & 64)) {
        gather_phase(F, l);
    }
}

template <int PH> __device__ __forceinline__ void run_all(unsigned char* lds, int lo, int hi) {
    if constexpr (PH < N_PHASES) {
        if (lo <= PH && PH < hi) {
            run_phase<PH>(lds);
            if (PH + 1 < hi) { Frame F; make_frame(F, lds); XcdBarrier bar; bar.bar = (unsigned*)(F.ctl + CW_BAR) + F.a->li * XCD_BAR_WORDS; bar.x = xb_xcc_id(); bar.st = F.MISC + 8; xcd_barrier(bar); }
        }
        run_all<PH + 1>(lds, lo, hi);
    }
}
__global__ void __launch_bounds__(NWAVES * 64, 2) mk_fwd(Args args) {
    extern __shared__ __attribute__((aligned(16))) unsigned char lds[];
    for (int u = threadIdx.x; u < (LDS_BYTES - LDSCTL_OFF) / 4; u += NWAVES * 64) ((LAS unsigned*)((LAS unsigned char*)lds + LDSCTL_OFF))[u] = 0u;
    __syncthreads();
    const int lo = args.ph_lo, hi = args.ph_hi;
    if (hi - lo > 1) (void)xcd_barrier_post((unsigned*)(args.ws + WS_CTL) + CW_BAR + args.li * XCD_BAR_WORDS, (volatile LAS unsigned*)((LAS unsigned char*)lds + MISC_OFF) + 8);
    run_all<0>(lds, lo, hi);
}

static int g_grid = 0;
static bool host_init() {
    if (g_grid != 0) return g_grid > 0;
    int dev = 0, cus = 0;
    if (hipGetDevice(&dev) != hipSuccess || hipDeviceGetAttribute(&cus, hipDeviceAttributeMultiprocessorCount, dev) != hipSuccess) { g_grid = -1; return false; }
    if (hipFuncSetAttribute((const void*)mk_fwd, hipFuncAttributeMaxDynamicSharedMemorySize, LDS_BYTES) != hipSuccess) { g_grid = -1; return false; }
    int per_cu = 0; (void)hipOccupancyMaxActiveBlocksPerMultiprocessor(&per_cu, (const void*)mk_fwd, NWAVES * 64, LDS_BYTES); (void)hipGetLastError();
    if (cus != 256 || per_cu < 1) { fprintf(stderr, "fast path needs 256 CUs (got %d), occupancy %d\n", cus, per_cu); g_grid = -1; return false; }
    g_grid = cus; return true;
}
static void zero_ctl(void* d_ws, hipStream_t st) { (void)hipMemsetAsync((char*)d_ws + WS_CTL, 0, CTL_ZERO_BYTES, st); }
static void launch(void* const* d_in, void* d_out, void* d_ws, int lo, int hi, int li, int parts, hipStream_t st) {
    Args a{}; for (int i = 0; i < 19; ++i) a.in[i] = (const float*)d_in[i];
    a.out = (float*)d_out; a.ws = (unsigned char*)d_ws; a.ph_lo = lo; a.ph_hi = hi; a.li = li; a.pad = parts;
    hipLaunchKernelGGL(mk_fwd, dim3(g_grid), dim3(NWAVES * 64), LDS_BYTES, st, a);
}
}

extern "C" void kernel_launch(void* const* d_in, const int* in_sizes, int n_in, void* d_out, int out_size, void* d_ws, size_t ws_size, hipStream_t stream) {
    if (!fx::host_init()) { nv::forward(d_in, (float*)d_out, (unsigned char*)d_ws, 0, stream); return; }
    fx::zero_ctl(d_ws, stream);
    fx::launch(d_in, d_out, d_ws, 0, fx::N_PHASES, 0, 7, stream);
}
```

```cpp
#include <hip/hip_runtime.h>
#include <hip/hip_bf16.h>
#include <cstdio>
#include <cstdint>
#include <cmath>

namespace nv {
constexpr int B = 8, S = 2048, D = 1024, M = B * S, INC = 2726;
constexpr float EPS = 1e-6f;

__device__ __forceinline__ float wsum(float v) {
#pragma unroll
    for (int o = 32; o >= 1; o >>= 1) v += __shfl_xor(v, o);
    return v;
}
__device__ __forceinline__ float logsig(float x) { return fminf(x, 0.f) - log1pf(expf(-fabsf(x))); }

__global__ void __launch_bounds__(256) rmsnorm(const float* x, int ldx, const float* g, float* out, int ldo, int rows, int width) {
    const int gw = (blockIdx.x * 256 + threadIdx.x) >> 6, lane = threadIdx.x & 63;
    if (gw >= rows) return;
    const float* xr = x + (size_t)gw * ldx; float* orow = out + (size_t)gw * ldo;
    float v[16]; float s = 0.f;
#pragma unroll
    for (int j = 0; j < 16; ++j) { const int c = j * 64 + lane; v[j] = (c < width) ? xr[c] : 0.f; s += v[j] * v[j]; }
    s = wsum(s);
    const float r = rsqrtf(s / (float)width + EPS);
#pragma unroll
    for (int j = 0; j < 16; ++j) { const int c = j * 64 + lane; if (c < width) orow[c] = v[j] * r * g[c]; }
}

__global__ void __launch_bounds__(256) gemm(const float* A, int lda, const float* Bm, int ldb, float* C, int ldc, const float* R, int ldr, int Mr, int N, int K) {
    __shared__ float As[16][64 + 4];
    __shared__ float Bs[16][64 + 4];
    const int tid = threadIdx.x, tx = tid & 15, ty = tid >> 4;
    const int m0 = blockIdx.y * 64, n0 = blockIdx.x * 64;
    float acc[4][4];
#pragma unroll
    for (int i = 0; i < 4; ++i)
#pragma unroll
        for (int j = 0; j < 4; ++j) acc[i][j] = 0.f;
    for (int k0 = 0; k0 < K; k0 += 16) {
#pragma unroll
        for (int i = 0; i < 4; ++i) { const int idx = tid + i * 256, r = idx >> 4, kk = idx & 15; As[kk][r] = A[(size_t)(m0 + r) * lda + k0 + kk]; }
#pragma unroll
        for (int i = 0; i < 4; ++i) { const int idx = tid + i * 256, kk = idx >> 6, c = idx & 63; Bs[kk][c] = (n0 + c < N) ? Bm[(size_t)(k0 + kk) * ldb + n0 + c] : 0.f; }
        __syncthreads();
#pragma unroll
        for (int kk = 0; kk < 16; ++kk) {
            float a[4], b[4];
#pragma unroll
            for (int i = 0; i < 4; ++i) a[i] = As[kk][ty * 4 + i];
#pragma unroll
            for (int j = 0; j < 4; ++j) b[j] = Bs[kk][tx * 4 + j];
#pragma unroll
            for (int i = 0; i < 4; ++i)
#pragma unroll
                for (int j = 0; j < 4; ++j) acc[i][j] = fmaf(a[i], b[j], acc[i][j]);
        }
        __syncthreads();
    }
#pragma unroll
    for (int i = 0; i < 4; ++i)
#pragma unroll
        for (int j = 0; j < 4; ++j) { const int r = m0 + ty * 4 + i, c = n0 + tx * 4 + j; if (c < N) C[(size_t)r * ldc + c] = acc[i][j] + (R ? R[(size_t)r * ldr + c] : 0.f); }
}

__global__ void fox_c(const float* proj, int ld, int off, const float* fb, float* c, int nb) {
    const int i = blockIdx.x * blockDim.x + threadIdx.x; if (i >= nb * 6) return;
    const int b = i / 6, h = i % 6; float acc = 0.f;
    for (int s = 0; s < S; ++s) { acc += logsig(proj[(size_t)(b * S + s) * ld + off + h] + fb[h]); c[(size_t)i * S + s] = acc; }
}

__global__ void rope(float* buf, int ld, int off, int nh, int hs, int rows) {
    const int i = blockIdx.x * blockDim.x + threadIdx.x; if (i >= rows * nh * 16) return;
    const int j = i & 15, h = (i >> 4) % nh, m = (i >> 4) / nh;
    const float inv = 1.0f / powf(10000.0f, (float)j / 16.0f);
    const float ang = (float)(m % S) * inv; const float cs = cosf(ang), sn = sinf(ang);
    float* p = buf + (size_t)m * ld + off + h * hs; const float x1 = p[j], x2 = p[16 + j];
    p[j] = x1 * cs - x2 * sn; p[16 + j] = x1 * sn + x2 * cs;
}
__global__ void copy_cols(const float* src, int lds_, int off, float* dst, int ldd, int width, int rows) {
    const int i = blockIdx.x * blockDim.x + threadIdx.x; if (i >= rows * width) return;
    const int m = i / width, c = i % width; dst[(size_t)m * ldd + c] = src[(size_t)m * lds_ + off + c];
}

template <int MODE, int DX>
__global__ void __launch_bounds__(64) attn(const float* Q, int ldq, int hsq, const float* K, int ldk, int hsk, const float* KX, int ldkx, int hskx,
                                           const float* V, int ldv, int hsv, float* O, int ldo, int hso, const float* cb, float scale) {
    constexpr int DQ = 64 + DX;
    __shared__ __attribute__((aligned(16))) float Ks[64][DQ];
    __shared__ __attribute__((aligned(16))) float Vs[64][64];
    __shared__ float cs[64];
    const int lane = threadIdx.x, qb = blockIdx.x, h = blockIdx.y, b = blockIdx.z, t = qb * 64 + lane;
    const size_t rowb = (size_t)b * S;
    float q[DQ], o[64];
#pragma unroll
    for (int d = 0; d < DQ; ++d) q[d] = Q[(rowb + t) * ldq + h * hsq + d] * scale;
#pragma unroll
    for (int d = 0; d < 64; ++d) o[d] = 0.f;
    const float ct = cb ? cb[((size_t)b * gridDim.y + h) * S + t] : 0.f;
    float mrun = -INFINITY, l = 0.f, R = 0.f;
    for (int it = 0; it <= qb; ++it) {
        const int kt = (MODE == 0) ? it : (qb - it);
        __syncthreads();
        for (int i = lane; i < 64 * 16; i += 64) { const int r = i >> 4, c4 = i & 15;
            *(float4*)&Ks[r][c4 * 4] = *(const float4*)&K[(rowb + kt * 64 + r) * ldk + h * hsk + c4 * 4];
            *(float4*)&Vs[r][c4 * 4] = *(const float4*)&V[(rowb + kt * 64 + r) * ldv + h * hsv + c4 * 4]; }
        if (DX > 0) for (int i = lane; i < 64 * (DX / 4); i += 64) { const int r = i / (DX / 4), c4 = i % (DX / 4);
            *(float4*)&Ks[r][64 + c4 * 4] = *(const float4*)&KX[(rowb + kt * 64 + r) * ldkx + h * hskx + c4 * 4]; }
        if (cb) cs[lane] = cb[((size_t)b * gridDim.y + h) * S + kt * 64 + lane];
        __syncthreads();
        for (int si = 0; si < 64; ++si) {
            const int sl = (MODE == 0) ? si : (63 - si); const int s = kt * 64 + sl;
            float dot = 0.f;
#pragma unroll
            for (int d = 0; d < DQ; d += 4) { const float4 kk = *(const float4*)&Ks[sl][d]; dot = fmaf(q[d], kk.x, dot); dot = fmaf(q[d + 1], kk.y, dot); dot = fmaf(q[d + 2], kk.z, dot); dot = fmaf(q[d + 3], kk.w, dot); }
            if (MODE == 0) {
                const bool valid = s <= t;
                const float logit = dot + (cb ? (ct - cs[sl]) : 0.f);
                if (valid) {
                    const float mn = fmaxf(mrun, logit), a = expf(mrun - mn), p = expf(logit - mn);
                    l = l * a + p; mrun = mn;
#pragma unroll
                    for (int d = 0; d < 64; d += 4) { const float4 vv = *(const float4*)&Vs[sl][d]; o[d] = o[d] * a + p * vv.x; o[d + 1] = o[d + 1] * a + p * vv.y; o[d + 2] = o[d + 2] * a + p * vv.z; o[d + 3] = o[d + 3] * a + p * vv.w; }
                }
            } else {
                const bool valid = s < t;
                if (valid) {
                    const float w = expf(logsig(dot) + R); R += logsig(-dot);
#pragma unroll
                    for (int d = 0; d < 64; d += 4) { const float4 vv = *(const float4*)&Vs[sl][d]; o[d] = fmaf(w, vv.x, o[d]); o[d + 1] = fmaf(w, vv.y, o[d + 1]); o[d + 2] = fmaf(w, vv.z, o[d + 2]); o[d + 3] = fmaf(w, vv.w, o[d + 3]); }
                }
            }
        }
    }
    const float inv = (MODE == 0) ? 1.0f / l : 1.0f;
#pragma unroll
    for (int d = 0; d < 64; ++d) O[(rowb + t) * ldo + h * hso + d] = o[d] * inv;
}

__global__ void __launch_bounds__(256) topk(const float* Q2, const float* keys1, const float* keys2, int* ids, float* gates) {
    const int gw = (blockIdx.x * 256 + threadIdx.x) >> 6, lane = threadIdx.x & 63;
    const int t = gw >> 3, h = gw & 7;
    const float* q = Q2 + (size_t)t * 2048 + h * 256;
    float s1a = 0.f, s1b = 0.f, s2a = 0.f, s2b = 0.f;
    for (int d = 0; d < 128; d += 4) {
        const float4 qa = *(const float4*)(q + d), qb = *(const float4*)(q + 128 + d);
        const float4 k1a = *(const float4*)(keys1 + lane * 128 + d), k1b = *(const float4*)(keys1 + (lane + 64) * 128 + d);
        const float4 k2a = *(const float4*)(keys2 + lane * 128 + d), k2b = *(const float4*)(keys2 + (lane + 64) * 128 + d);
        s1a += qa.x * k1a.x + qa.y * k1a.y + qa.z * k1a.z + qa.w * k1a.w; s1b += qa.x * k1b.x + qa.y * k1b.y + qa.z * k1b.z + qa.w * k1b.w;
        s2a += qb.x * k2a.x + qb.y * k2a.y + qb.z * k2a.z + qb.w * k2a.w; s2b += qb.x * k2b.x + qb.y * k2b.y + qb.z * k2b.z + qb.w * k2b.w;
    }
    float top1 = 0.f, top2 = 0.f; int idx1 = 0, idx2 = 0;
#pragma unroll
    for (int side = 0; side < 2; ++side) {
        float v0 = side ? s2a : s1a, v1 = side ? s2b : s1b; float tp = 0.f; int ti = 0;
        for (int k = 0; k < 16; ++k) {
            float bv; int bi; if (v0 >= v1) { bv = v0; bi = lane; } else { bv = v1; bi = lane + 64; }
#pragma unroll
            for (int o = 32; o >= 1; o >>= 1) { const float ov = __shfl_xor(bv, o); const int oi = __shfl_xor(bi, o); if (ov > bv || (ov == bv && oi < bi)) { bv = ov; bi = oi; } }
            if (lane == k) { tp = bv; ti = bi; }
            if (bi == lane) v0 = -INFINITY; if (bi == lane + 64) v1 = -INFINITY;
        }
        if (side) { top2 = tp; idx2 = ti; } else { top1 = tp; idx1 = ti; }
    }
    const float a = __shfl(top1, lane >> 2); const int ia = __shfl(idx1, lane >> 2);
    float c0, c1, c2, c3; int e0, e1, e2, e3;
    { const int jb = (lane & 3) * 4;
      c0 = a + __shfl(top2, jb + 0); e0 = ia * 128 + __shfl(idx2, jb + 0);
      c1 = a + __shfl(top2, jb + 1); e1 = ia * 128 + __shfl(idx2, jb + 1);
      c2 = a + __shfl(top2, jb + 2); e2 = ia * 128 + __shfl(idx2, jb + 2);
      c3 = a + __shfl(top2, jb + 3); e3 = ia * 128 + __shfl(idx2, jb + 3); }
    float best = 0.f; int bid = 0;
    for (int k = 0; k < 16; ++k) {
        float bv = c0; int bc = lane * 4, be = e0;
        if (c1 > bv) { bv = c1; bc = lane * 4 + 1; be = e1; }
        if (c2 > bv) { bv = c2; bc = lane * 4 + 2; be = e2; }
        if (c3 > bv) { bv = c3; bc = lane * 4 + 3; be = e3; }
#pragma unroll
        for (int o = 32; o >= 1; o >>= 1) { const float ov = __shfl_xor(bv, o); const int oc = __shfl_xor(bc, o), oe = __shfl_xor(be, o); if (ov > bv || (ov == bv && oc < bc)) { bv = ov; bc = oc; be = oe; } }
        if (lane == k) { best = bv; bid = be; }
        if (bc == lane * 4) c0 = -INFINITY; if (bc == lane * 4 + 1) c1 = -INFINITY; if (bc == lane * 4 + 2) c2 = -INFINITY; if (bc == lane * 4 + 3) c3 = -INFINITY;
    }
    const float mx = __shfl(best, 0);
    float e = (lane < 16) ? expf(best - mx) : 0.f;
    const float sum = wsum(e);
    if (lane < 16) { ids[(size_t)gw * 16 + lane] = bid; gates[(size_t)gw * 16 + lane] = e / sum; }
}

__global__ void __launch_bounds__(256) peer_gather(const float* H2, const float* X1, const int* ids, const float* gates, const float* U, const float* Vw, float* Xout) {
    const int t = (blockIdx.x * 256 + threadIdx.x) >> 6, lane = threadIdx.x & 63;
    float4 hv[4], acc[4];
#pragma unroll
    for (int j = 0; j < 4; ++j) { hv[j] = *(const float4*)(H2 + (size_t)t * D + j * 256 + lane * 4); acc[j] = make_float4(0.f, 0.f, 0.f, 0.f); }
    for (int e = 0; e < 128; ++e) {
        const int id = __builtin_amdgcn_readfirstlane(ids[(size_t)t * 128 + e]);
        const float gt = gates[(size_t)t * 128 + e];
        const float* ur = U + (size_t)id * D; const float* vr = Vw + (size_t)id * D;
        float p = 0.f;
#pragma unroll
        for (int j = 0; j < 4; ++j) { const float4 u4 = *(const float4*)(ur + j * 256 + lane * 4); p += hv[j].x * u4.x + hv[j].y * u4.y + hv[j].z * u4.z + hv[j].w * u4.w; }
        p = wsum(p);
        const float a = 0.5f * p * (1.0f + erff(p * 0.70710678118654752f)) * gt;
#pragma unroll
        for (int j = 0; j < 4; ++j) { const float4 v4 = *(const float4*)(vr + j * 256 + lane * 4); acc[j].x = fmaf(a, v4.x, acc[j].x); acc[j].y = fmaf(a, v4.y, acc[j].y); acc[j].z = fmaf(a, v4.z, acc[j].z); acc[j].w = fmaf(a, v4.w, acc[j].w); }
    }
#pragma unroll
    for (int j = 0; j < 4; ++j) { const float4 x4 = *(const float4*)(X1 + (size_t)t * D + j * 256 + lane * 4);
        *(float4*)(Xout + (size_t)t * D + j * 256 + lane * 4) = make_float4(x4.x + acc[j].x, x4.y + acc[j].y, x4.z + acc[j].z, x4.w + acc[j].w); }
}

struct Bufs { float *H, *PROJ, *Y, *X1, *Q2, *QUP, *KVUP, *CQN, *CKVN, *KR, *C, *GATES; int* IDS; };
static size_t carve(unsigned char* ws, size_t off, int rows, Bufs& b) {
    auto take = [&](size_t bytes) { unsigned char* p = ws + off; off += (bytes + 255) & ~(size_t)255; return p; };
    unsigned char* regionA = take((size_t)rows * INC * 4 + (size_t)rows * D * 4);
    b.PROJ = (float*)regionA; b.Y = (float*)(regionA + (size_t)rows * INC * 4); b.Q2 = (float*)regionA;
    b.H = (float*)take((size_t)rows * D * 4);
    b.QUP = (float*)take((size_t)rows * 384 * 4); b.KVUP = (float*)take((size_t)rows * 512 * 4); b.CQN = (float*)take((size_t)rows * 256 * 4); b.CKVN = (float*)take((size_t)rows * 128 * 4);
    b.KR = (float*)take((size_t)rows * 32 * 4); b.C = (float*)take((size_t)(rows / S) * 6 * S * 4); b.GATES = (float*)take((size_t)rows * 128 * 4); b.IDS = (int*)take((size_t)rows * 128 * 4);
    return off;
}
static void mixer(void* const* d_in, int l, const float* xin, const Bufs& b, int rows, int from, hipStream_t st) {
    const int nb = rows / S;
    const float* attn_g = (const float*)d_in[1] + (size_t)l * D; const float* w_in = (const float*)d_in[2] + (size_t)l * D * INC; const float* fb = (const float*)d_in[3] + l * 6;
    const float* qg = (const float*)d_in[4] + l * 256; const float* w_uq = (const float*)d_in[5] + (size_t)l * 256 * 384; const float* kvg = (const float*)d_in[6] + l * 128;
    const float* w_ukv = (const float*)d_in[7] + (size_t)l * 128 * 512; const float* g_fox = (const float*)d_in[8] + l * 384; const float* g_mla = (const float*)d_in[9] + l * 256;
    const float* g_sb = (const float*)d_in[10] + l * 384; const float* w_out = (const float*)d_in[11] + (size_t)l * D * D;
    if (from <= 0) {
        rmsnorm<<<rows / 4, 256, 0, st>>>(xin, D, attn_g, b.H, D, rows, D);
        gemm<<<dim3((INC + 63) / 64, rows / 64), 256, 0, st>>>(b.H, D, w_in, INC, b.PROJ, INC, nullptr, 0, rows, INC, D);
    }
    if (from <= 2) {
        fox_c<<<1, 64, 0, st>>>(b.PROJ, INC, 1152, fb, b.C, nb);
        attn<0, 0><<<dim3(S / 64, 6, nb), 64, 0, st>>>(b.PROJ, INC, 64, b.PROJ + 384, INC, 64, nullptr, 0, 0, b.PROJ + 768, INC, 64, b.Y, D, 64, b.C, 0.125f);
        if (from <= 1) {
            rmsnorm<<<rows / 4, 256, 0, st>>>(b.PROJ + 1158, INC, qg, b.CQN, 256, rows, 256);
            gemm<<<dim3(384 / 64, rows / 64), 256, 0, st>>>(b.CQN, 256, w_uq, 384, b.QUP, 384, nullptr, 0, rows, 384, 256);
            rope<<<(rows * 4 * 16 + 255) / 256, 256, 0, st>>>(b.QUP, 384, 64, 4, 96, rows);
            rmsnorm<<<rows / 4, 256, 0, st>>>(b.PROJ + 1414, INC, kvg, b.CKVN, 128, rows, 128);
            gemm<<<dim3(512 / 64, rows / 64), 256, 0, st>>>(b.CKVN, 128, w_ukv, 512, b.KVUP, 512, nullptr, 0, rows, 512, 128);
            copy_cols<<<(rows * 32 + 255) / 256, 256, 0, st>>>(b.PROJ, INC, 1542, b.KR, 32, 32, rows);
            rope<<<(rows * 16 + 255) / 256, 256, 0, st>>>(b.KR, 32, 0, 1, 0, rows);
        }
        attn<0, 32><<<dim3(S / 64, 4, nb), 64, 0, st>>>(b.QUP, 384, 96, b.KVUP, 512, 128, b.KR, 32, 0, b.KVUP + 64, 512, 128, b.Y + 384, D, 64, nullptr, 0.10206207261596577f);
        attn<1, 0><<<dim3(S / 64, 6, nb), 64, 0, st>>>(b.PROJ + 1574, INC, 64, b.PROJ + 1958, INC, 64, nullptr, 0, 0, b.PROJ + 2342, INC, 64, b.Y + 640, D, 64, nullptr, 0.125f);
    }
    rmsnorm<<<rows / 4, 256, 0, st>>>(b.Y, D, g_fox, b.Y, D, rows, 384);
    rmsnorm<<<rows / 4, 256, 0, st>>>(b.Y + 384, D, g_mla, b.Y + 384, D, rows, 256);
    rmsnorm<<<rows / 4, 256, 0, st>>>(b.Y + 640, D, g_sb, b.Y + 640, D, rows, 384);
    gemm<<<dim3(D / 64, rows / 64), 256, 0, st>>>(b.Y, D, w_out, D, b.X1, D, xin, D, rows, D, D);
}
static void peer(void* const* d_in, int l, const Bufs& b, float* xout, int rows, int from, const int* ids_in, const float* gates_in, hipStream_t st) {
    const float* ffn_g = (const float*)d_in[12] + (size_t)l * D; const float* wq = (const float*)d_in[13] + (size_t)l * D * 2048;
    const float* k1 = (const float*)d_in[14] + (size_t)l * 128 * 128; const float* k2 = (const float*)d_in[15] + (size_t)l * 128 * 128;
    const float* U = (const float*)d_in[16] + (size_t)l * 16384 * D; const float* Vw = (const float*)d_in[17] + (size_t)l * 16384 * D;
    rmsnorm<<<rows / 4, 256, 0, st>>>(b.X1, D, ffn_g, b.H, D, rows, D);
    const int* ids = b.IDS; const float* gates = b.GATES;
    if (from <= 0) {
        gemm<<<dim3(2048 / 64, rows / 64), 256, 0, st>>>(b.H, D, wq, 2048, b.Q2, 2048, nullptr, 0, rows, 2048, D);
        topk<<<rows * 8 / 4, 256, 0, st>>>(b.Q2, k1, k2, b.IDS, b.GATES);
    } else { ids = ids_in; gates = gates_in; }
    peer_gather<<<rows / 4, 256, 0, st>>>(b.H, b.X1, ids, gates, U, Vw, xout);
}
static void forward(void* const* d_in, float* d_out, unsigned char* ws, size_t off, hipStream_t st) {
    Bufs b; off = carve(ws, off, M, b); b.X1 = d_out; float* X2 = (float*)(ws + off);
    const float* x = (const float*)d_in[0];
    mixer(d_in, 0, x, b, M, 0, st); peer(d_in, 0, b, X2, M, 0, nullptr, nullptr, st);
    mixer(d_in, 1, X2, b, M, 0, st); peer(d_in, 1, b, X2, M, 0, nullptr, nullptr, st);
    rmsnorm<<<M / 4, 256, 0, st>>>(X2, D, (const float*)d_in[18], d_out, D, M, D);
}
}

namespace pg8 {

#define PG8_LAS __attribute__((address_space(3)))
typedef unsigned short bf16_t;
typedef short bf16x8 __attribute__((ext_vector_type(8)));
typedef float f32x4 __attribute__((ext_vector_type(4)));
typedef unsigned u32x4 __attribute__((ext_vector_type(4)));
constexpr int BM = 256, BK = 64, HALF = 128, HTB = HALF * BK * 2  , STAGE_BYTES = 8 * HTB, NXCD = 8, WGM = 8;

__host__ __device__ __forceinline__ int lds_byte(int r, int c) { const int st = (r >> 4) * 2 + (c >> 5), rr = r & 15, cc = c & 31, ob = rr * 64 + cc * 2; return st * 1024 + (ob ^ (((ob >> 9) & 1) << 5)); }
__host__ __device__ __forceinline__ void stage_rc(int b, int& R, int& C) { const int st = b / 1024, sb = b % 1024, swz = sb ^ (((sb >> 9) & 1) << 5); R = (st >> 1) * 16 + swz / 64; C = (st & 1) * 32 + (swz % 64) / 2; }
__host__ __device__ __forceinline__ int perm32(int rho) { const int n = rho >> 4, i = rho & 15; return 8 * (i >> 2) + 4 * n + (i & 3); }

struct Unit { int pm, pn; };
struct Gemm { const bf16_t* A; const bf16_t* Bt; int M, N, K, lda, ldb; };

struct StaticOrder {
    int nM, nN, nwg, G, c;
    __host__ __device__ __forceinline__ void init(int M, int N, int G_, int c_) { nM = M / BM; nN = N / BM; nwg = nM * nN; G = G_; c = c_; }
    __host__ __device__ __forceinline__ bool next(int i, Unit& u) const {
        const long L = (long)i * G + c; if (L >= nwg) return false;
        int wgid = (int)L; { const int q = nwg / NXCD, r = nwg % NXCD, xcd = wgid % NXCD, off = wgid / NXCD; wgid = (xcd < r ? xcd * (q + 1) : r * (q + 1) + (xcd - r) * q) + off; }
        const int nig = WGM * nN, gid = wgid / nig, fm = gid * WGM, gsz = (nM - fm) < WGM ? (nM - fm) : WGM;
        u.pm = fm + ((wgid % nig) % gsz); u.pn = (wgid % nig) / gsz; return true;
    }
    __device__ __forceinline__ void a_ready(const Unit&) const {}
    __device__ __forceinline__ void done(const Unit&) const {}
};

template <class Epi, class Sched, bool ALIGN_EPI = false, bool SP2 = false>
__device__ __forceinline__ void gemm_phase(PG8_LAS unsigned char* lds, const Gemm g, const Sched& S, const Epi& E) {
    int tid_ = threadIdx.x; asm volatile("" : "+v"(tid_));
    const int tid = tid_, wid = __builtin_amdgcn_readfirstlane(tid >> 6), lane = tid & 63, wr = wid >> 2, wc = wid & 3, fr = lane & 15, fq = lane >> 4;
    const int K = g.K, nt = K / BK;
    unsigned voffA[2], voffB[2];
#pragma unroll
    for (int i = 0; i < 2; ++i) { int R, C; stage_rc(tid * 16 + i * 8192, R, C); const int Rb = Epi::PERM ? ((R & ~31) + perm32(R & 31)) : R;
        voffA[i] = (unsigned)(R * g.lda + C) * 2u; voffB[i] = (unsigned)(Rb * g.ldb + C) * 2u; }
    const size_t kstep = (size_t)(BK * 2);
    const size_t hstepA = (size_t)HALF * g.lda * 2, hstepB = (size_t)HALF * g.ldb * 2;
    const size_t tstepA = 2 * hstepA, tstepB = 2 * hstepB;
    const unsigned ldsw = (unsigned)wid * 1024u;
    const int aoff = lds_byte(wr * 64 + fr, fq * 8), boff = lds_byte(wc * 32 + fr, fq * 8);
#define PG8_SA(b, h) (((b) * 2 + (h)) * HTB)
#define PG8_SB(b, h) ((4 + (b) * 2 + (h)) * HTB)
#define PG8_STAGE(bufoff, gbase, voff) do { _Pragma("unroll") for (int _i = 0; _i < 2; ++_i) \
        __builtin_amdgcn_global_load_lds((const unsigned*)((const char*)(gbase) + (voff)[_i]), (PG8_LAS unsigned*)(lds + (bufoff) + ldsw + _i * 8192), 16, 0, 0); } while (0)
#define PG8_LDA(dst, b, h) do { _Pragma("unroll") for (int m = 0; m < 4; ++m) _Pragma("unroll") for (int k = 0; k < 2; ++k) dst[m][k] = *(const PG8_LAS bf16x8*)(lds + PG8_SA(b, h) + aoff + m * 2048 + k * 1024); } while (0)
#define PG8_LDB(dst, b, h) do { _Pragma("unroll") for (int n = 0; n < 2; ++n) _Pragma("unroll") for (int k = 0; k < 2; ++k) dst[n][k] = *(const PG8_LAS bf16x8*)(lds + PG8_SB(b, h) + boff + n * 2048 + k * 1024); } while (0)
#define PG8_MMA(ai, bj, At, Bt) do { __builtin_amdgcn_s_setprio(1); _Pragma("unroll") for (int m = 0; m < 4; ++m) _Pragma("unroll") for (int n = 0; n < 2; ++n) _Pragma("unroll") for (int k = 0; k < 2; ++k) \
        acc[ai][bj][m][n] = __builtin_amdgcn_mfma_f32_16x16x32_bf16(Bt[n][k], At[m][k], acc[ai][bj][m][n], 0, 0, 0); __builtin_amdgcn_s_setprio(0); } while (0)
#define PG8_WAIT_V(n) asm volatile("s_waitcnt vmcnt(" #n ")" ::: "memory")
#define PG8_WAIT_L(n) asm volatile("s_waitcnt lgkmcnt(" #n ")" ::: "memory")
#define PG8_BAR __builtin_amdgcn_s_barrier()
#define PG8_SCHED __builtin_amdgcn_sched_barrier(0)
    Unit cur, nxt; int ui = 0;
    if (!S.next(0, cur)) return;
    f32x4 acc[2][2][4][2];
    float zf_ = 0.f; asm volatile("" : "+v"(zf_));
#pragma unroll
    for (int a = 0; a < 2; ++a)
#pragma unroll
        for (int b = 0; b < 2; ++b)
#pragma unroll
            for (int m = 0; m < 4; ++m)
#pragma unroll
                for (int n = 0; n < 2; ++n) acc[a][b][m][n] = (f32x4){zf_, zf_, zf_, zf_};
    bf16x8 At[4][2], B0[2][2], B1[2][2];
    const char* cA = (const char*)g.A + (size_t)cur.pm * tstepA; const char* cB = (const char*)g.Bt + (size_t)cur.pn * tstepB;
    S.a_ready(cur);
    if constexpr (SP2) {
        PG8_STAGE(PG8_SB(0, 0), cB, voffB); PG8_STAGE(PG8_SB(0, 1), cB + hstepB, voffB); PG8_STAGE(PG8_SA(0, 0), cA, voffA); PG8_STAGE(PG8_SA(0, 1), cA + hstepA, voffA);
        if (wr == 1) PG8_BAR;
        PG8_WAIT_V(2); PG8_BAR;
        PG8_STAGE(PG8_SB(1, 0), cB + kstep, voffB); PG8_STAGE(PG8_SA(1, 0), cA + kstep, voffA); PG8_STAGE(PG8_SB(1, 1), cB + hstepB + kstep, voffB);
        PG8_WAIT_V(6); PG8_BAR;
    } else {
        PG8_STAGE(PG8_SB(0, 0), cB, voffB); PG8_STAGE(PG8_SA(0, 0), cA, voffA); PG8_STAGE(PG8_SB(0, 1), cB + hstepB, voffB); PG8_STAGE(PG8_SA(0, 1), cA + hstepA, voffA);
        if (wr == 1) PG8_BAR;
        PG8_WAIT_V(4); PG8_BAR;
        PG8_STAGE(PG8_SB(1, 0), cB + kstep, voffB); PG8_STAGE(PG8_SA(1, 0), cA + kstep, voffA); PG8_STAGE(PG8_SB(1, 1), cB + hstepB + kstep, voffB);
        PG8_WAIT_V(6); PG8_BAR;
    }
    for (;;) {
        const bool has_next = S.next(ui + 1, nxt);
        const char* nA = has_next ? (const char*)g.A + (size_t)nxt.pm * tstepA : cA; const char* nB = has_next ? (const char*)g.Bt + (size_t)nxt.pn * tstepB : cB;
#pragma unroll 1
        for (int t = 0; t < nt; t += 2) {
            const bool last = (t == nt - 2);
            const char* a1 = cA + (size_t)(t + 1) * kstep;
            const char* a2 = last ? nA : cA + (size_t)(t + 2) * kstep; const char* b2 = last ? nB : cB + (size_t)(t + 2) * kstep;
            const char* a3 = a2 + kstep; const char* b3 = b2 + kstep;
            if (last && has_next) S.a_ready(nxt);
            if constexpr (Epi::HAS_MID) { if (t == Epi::MID0 || t == Epi::MID1) E.mid(acc, t, wr, fr); }
            if constexpr (SP2) {
            PG8_LDB(B0, 0, 0); PG8_LDB(B1, 0, 1); PG8_SCHED; PG8_LDA(At, 0, 0); PG8_STAGE(PG8_SA(1, 1), a1 + hstepA, voffA);
            PG8_WAIT_V(8); PG8_WAIT_L(0); PG8_BAR; PG8_MMA(0, 0, At, B0); PG8_MMA(0, 1, At, B1); PG8_BAR; PG8_SCHED;
            PG8_LDA(At, 0, 1); PG8_STAGE(PG8_SB(0, 0), b2, voffB); PG8_STAGE(PG8_SB(0, 1), b2 + hstepB, voffB); PG8_STAGE(PG8_SA(0, 0), a2, voffA);
            PG8_WAIT_V(8); PG8_WAIT_L(0); PG8_BAR; PG8_MMA(1, 0, At, B0); PG8_MMA(1, 1, At, B1); PG8_BAR; PG8_SCHED;
            PG8_LDB(B0, 1, 0); PG8_LDB(B1, 1, 1); PG8_SCHED; PG8_LDA(At, 1, 0); PG8_STAGE(PG8_SA(0, 1), a2 + hstepA, voffA);
            PG8_WAIT_V(8); PG8_WAIT_L(0); PG8_BAR; PG8_MMA(0, 0, At, B0); PG8_MMA(0, 1, At, B1); PG8_BAR; PG8_SCHED;
            PG8_LDA(At, 1, 1); PG8_STAGE(PG8_SB(1, 0), b3, voffB); PG8_STAGE(PG8_SB(1, 1), b3 + hstepB, voffB); PG8_STAGE(PG8_SA(1, 0), a3, voffA);
            PG8_WAIT_V(8); PG8_WAIT_L(0); PG8_BAR; PG8_MMA(1, 0, At, B0); PG8_MMA(1, 1, At, B1); PG8_BAR; PG8_SCHED;
            } else {
            PG8_LDB(B0, 0, 0); PG8_SCHED; PG8_LDA(At, 0, 0); PG8_STAGE(PG8_SA(1, 1), a1 + hstepA, voffA);
            PG8_WAIT_L(8); PG8_BAR; PG8_WAIT_L(0); PG8_MMA(0, 0, At, B0); PG8_BAR; PG8_SCHED;
            PG8_LDB(B1, 0, 1); PG8_STAGE(PG8_SB(0, 0), b2, voffB);
            PG8_BAR; PG8_WAIT_L(0); PG8_MMA(0, 1, At, B1); PG8_BAR;
            PG8_LDA(At, 0, 1); PG8_STAGE(PG8_SA(0, 0), a2, voffA);
            PG8_BAR; PG8_WAIT_L(0); PG8_MMA(1, 0, At, B0); PG8_BAR; PG8_SCHED;
            PG8_STAGE(PG8_SB(0, 1), b2 + hstepB, voffB);
            PG8_WAIT_V(6); PG8_BAR; PG8_MMA(1, 1, At, B1); PG8_BAR;
            PG8_LDB(B0, 1, 0); PG8_SCHED; PG8_LDA(At, 1, 0); PG8_STAGE(PG8_SA(0, 1), a2 + hstepA, voffA);
            PG8_WAIT_L(8); PG8_BAR; PG8_WAIT_L(0); PG8_MMA(0, 0, At, B0); PG8_BAR; PG8_SCHED;
            PG8_LDB(B1, 1, 1); PG8_STAGE(PG8_SB(1, 0), b3, voffB);
            PG8_BAR; PG8_WAIT_L(0); PG8_MMA(0, 1, At, B1); PG8_BAR;
            PG8_LDA(At, 1, 1); PG8_STAGE(PG8_SA(1, 0), a3, voffA);
            PG8_BAR; PG8_WAIT_L(0); PG8_MMA(1, 0, At, B0); PG8_BAR; PG8_SCHED;
            PG8_STAGE(PG8_SB(1, 1), b3 + hstepB, voffB);
            PG8_WAIT_V(6); PG8_BAR; PG8_MMA(1, 1, At, B1); PG8_BAR;
            }
        }
        if constexpr (ALIGN_EPI) { if (wr == 0) PG8_BAR; }
        if constexpr (!Epi::AFTER_DRAIN) { E(acc, cur, wr, wc, fr, fq); S.done(cur); }
        if (!has_next) break;
#pragma unroll
        for (int a = 0; a < 2; ++a)
#pragma unroll
            for (int b = 0; b < 2; ++b)
#pragma unroll
                for (int m = 0; m < 4; ++m)
#pragma unroll
                    for (int n = 0; n < 2; ++n) acc[a][b][m][n] = (f32x4){zf_, zf_, zf_, zf_};
        cur = nxt; cA = nA; cB = nB; ++ui;
        if constexpr (ALIGN_EPI) { if (wr == 1) PG8_BAR; }
    }
    PG8_WAIT_V(0);
    if constexpr (!ALIGN_EPI) { if (wr == 0) PG8_BAR; }
    PG8_BAR;
    if constexpr (Epi::AFTER_DRAIN) { E.fused(acc, cur, wr, wc, fr, fq, lds, wid, lane); S.done(cur); }
#undef PG8_SA
#undef PG8_SB
#undef PG8_STAGE
#undef PG8_LDA
#undef PG8_LDB
#undef PG8_MMA
#undef PG8_WAIT_V
#undef PG8_WAIT_L
#undef PG8_BAR
#undef PG8_SCHED
}
}

#ifndef MK_UEXP
#define MK_UEXP 0
#ifndef MK_CONVQ
#define MK_CONVQ 1
#endif
#endif
namespace fx {
using pg8::bf16_t; using pg8::f32x4; using pg8::u32x4; using pg8::bf16x8;
typedef unsigned u32x2 __attribute__((ext_vector_type(2)));
typedef float f32x2 __attribute__((ext_vector_type(2)));
constexpr int B = 8, S = 2048, D = 1024, M = B * S, INC = 2726, NP = 2816;
constexpr float EPS = 1e-6f, LOG2E = 1.4426950408889634f;
constexpr float C2 = 0.125f * LOG2E;
constexpr float C2M = 0.10206207261596577f * LOG2E;
constexpr int PC_FQ = 0, PC_FK = 384, PC_FV = 768, PC_SQ = 1152, PC_SK = 1536, PC_SV = 1920, PC_CQ = 2304, PC_CKV = 2560, PC_KR = 2688, PC_FL = 2720;
constexpr int NWAVES = 8;
constexpr size_t MiB = 1u << 20;
constexpr size_t WS_CTL = 0, CTL_ZERO_BYTES = 1 * MiB;
constexpr size_t WS_WIN = 1 * MiB, WIN_L = (size_t)NP * D * 2;
constexpr size_t WS_WMLA = 12 * MiB, WMLA_L = (size_t)1024 * 384 * 2;
constexpr size_t WS_WOUT = 14 * MiB, WOUT_L = (size_t)D * D * 2;
constexpr size_t WS_WQ = 18 * MiB, WQ_L = (size_t)2048 * D * 2;
constexpr size_t WS_KEYS = 26 * MiB;
constexpr size_t WS_ROPE = 26 * MiB + 512 * 1024;
constexpr size_t WS_UB = 27 * MiB, UB_L = (size_t)16384 * D;
constexpr size_t WS_VB = 91 * MiB;
constexpr size_t WS_XN = 155 * MiB;
constexpr size_t WS_PROJ = 187 * MiB;
constexpr size_t WS_QUP = 275 * MiB, WS_KVUP = 287 * MiB, WS_KR = 303 * MiB, WS_KEXT = 304 * MiB;
constexpr size_t WS_FLOG = 307 * MiB, WS_SSQQ = 307 * MiB + 512 * 1024, WS_SSQKV = 307 * MiB + 768 * 1024;
constexpr size_t WS_Y = 308 * MiB;
constexpr size_t WS_PART = WS_PROJ;
constexpr size_t WS_QF = WS_PROJ;
constexpr size_t WS_SSQH = 340 * MiB, WS_SSQX = 341 * MiB, WS_X1B = 342 * MiB, WS_X2 = 374 * MiB, WS_IDS = 438 * MiB, WS_GATES = 446 * MiB, WS_SSQ2 = 454 * MiB  , WS_RSX = 454 * MiB + 512 * 1024  , WS_XQ = 455 * MiB  , WS_AVB = 471 * MiB  , WS_AH = 475 * MiB, WS_AL = 477 * MiB  , WS_END = 479 * MiB;
static_assert(WS_QF + (size_t)M * 2048 * 4 <= WS_SSQH, "Q overlay");
constexpr int CW_BAR = 4096, CW_ATTQ = 16384;
constexpr int RING_BYTES = 131072, LDSCTL_OFF = RING_BYTES, MISC_OFF = LDSCTL_OFF + 320, FAC_OFF = RING_BYTES + 1024, LDS_BYTES = 147456;
static_assert(FAC_OFF + 3 * 256 * 4 <= LDS_BYTES, "lds map");

#define GAS __attribute__((address_space(1)))
#define LAS __attribute__((address_space(3)))
typedef unsigned v4u __attribute__((ext_vector_type(4)));
typedef GAS unsigned gu32;
#define RLX_AGENT __ATOMIC_RELAXED, __HIP_MEMORY_SCOPE_AGENT
#define LDS_WAIT() asm volatile("s_waitcnt lgkmcnt(0)" ::: "memory")
#define VM_WAIT() asm volatile("s_waitcnt vmcnt(0)" ::: "memory")
__device__ __forceinline__ unsigned f2bf(float f) { unsigned u = __builtin_bit_cast(unsigned, f); return (u + 0x7fffu + ((u >> 16) & 1u)) >> 16; }
__device__ __forceinline__ unsigned pk2(float lo, float hi) { return f2bf(lo) | (f2bf(hi) << 16); }
__device__ __forceinline__ float bf2f(unsigned short b) { return __builtin_bit_cast(float, (unsigned)b << 16); }
__device__ __forceinline__ unsigned cvt_pk(float lo, float hi) { typedef float f2 __attribute__((ext_vector_type(2))); typedef __bf16 b2 __attribute__((ext_vector_type(2))); f2 v = {lo, hi}; b2 b = __builtin_convertvector(v, b2); return __builtin_bit_cast(unsigned, b); }
__device__ __forceinline__ float wave_sum(float v) {
#pragma unroll
    for (int o = 1; o < 64; o <<= 1) v += __shfl_xor(v, o);
    return v;
}

#define XB_TMO      128
#define XB_XCNT(j)  (256  + 64 * (j))
#define XB_XSUB(j)  (1280 + 64 * (j))
#define XB_XGEN(j)  (2304 + 64 * (j))
#define XB_TOP      3328
#define XB_TOPGEN   3392
#define XCD_BAR_WORDS 3456
#define XB_SPIN_CAP (1u << 20)
__device__ __forceinline__ unsigned xb_ld(unsigned* p)              { return __hip_atomic_load(p, __ATOMIC_RELAXED, __HIP_MEMORY_SCOPE_AGENT); }
__device__ __forceinline__ unsigned xb_add(unsigned* p, unsigned v) { return __hip_atomic_fetch_add(p, v, __ATOMIC_RELAXED, __HIP_MEMORY_SCOPE_AGENT); }
__device__ __forceinline__ unsigned xb_xcc_id() { return (unsigned)__builtin_amdgcn_s_getreg((3 << 11) | 20) & 0xFu; }
#define XB_SPIN(cond, bar) do { unsigned _sp = 0; while (cond) { __builtin_amdgcn_s_sleep(1); \
    if ((++_sp & 255u) == 0u) { if (xb_ld(&(bar)[XB_TMO])) break; if (_sp > XB_SPIN_CAP) { atomicAdd(&(bar)[XB_TMO], 1u); break; } } } } while (0)
struct XcdBarrier { unsigned* bar; unsigned x; volatile LAS unsigned* st; };
__device__ __forceinline__ XcdBarrier xcd_barrier_post(unsigned* bar, volatile LAS unsigned* st) {
    XcdBarrier b; b.bar = bar; b.x = xb_xcc_id(); b.st = st;
    if (threadIdx.x == 0) (void)xb_add(&bar[XB_XCNT(b.x)], 1u);
    return b;
}
__device__ __forceinline__ void xcd_barrier_complete(unsigned* bar, unsigned x, unsigned& nloc, unsigned& nx) {
    const unsigned G = gridDim.x * gridDim.y * gridDim.z;
    unsigned sum, cnt, mine, sp = 0u;
    for (;;) {
        sum = 0u; cnt = 0u; mine = 0u;
#pragma unroll
        for (unsigned j = 0; j < 16; ++j) { const unsigned c = xb_ld(&bar[XB_XCNT(j)]); sum += c; cnt += (c > 0u) ? 1u : 0u; mine = (j == x) ? c : mine; }
        if (sum == G) break;
        __builtin_amdgcn_s_sleep(1);
        if ((++sp & 255u) == 0u) { if (xb_ld(&bar[XB_TMO])) break; if (sp > XB_SPIN_CAP) { atomicAdd(&bar[XB_TMO], 1u); break; } }
    }
    nloc = mine > 0u ? mine : 1u; nx = cnt > 0u ? cnt : 1u;
}
__device__ __forceinline__ void xcd_barrier(const XcdBarrier& b) {
    asm volatile("s_waitcnt vmcnt(0)" ::: "memory");
    __syncthreads();
    if (threadIdx.x == 0) {
        unsigned* bar = b.bar;
        __builtin_amdgcn_s_waitcnt(0);
        unsigned nloc = b.st[0], nx = b.st[1];
        if (nloc == 0u) { xcd_barrier_complete(bar, b.x, nloc, nx); b.st[0] = nloc; b.st[1] = nx; }
        const unsigned old = xb_add(&bar[XB_XSUB(b.x)], 1u);
        const unsigned gen = old / nloc;
        if (old + 1u == (gen + 1u) * nloc) {
            __builtin_amdgcn_fence(__ATOMIC_RELEASE, "agent");
            asm volatile("s_waitcnt vmcnt(0)" ::: "memory");
            const unsigned og = xb_add(&bar[XB_TOP], 1u);
            const unsigned tg = og / nx;
            if (og + 1u == (tg + 1u) * nx) xb_add(&bar[XB_TOPGEN], 1u);
            else XB_SPIN(xb_ld(&bar[XB_TOPGEN]) == tg, bar);
            __builtin_amdgcn_fence(__ATOMIC_ACQUIRE, "agent");
            xb_add(&bar[XB_XGEN(b.x)], 1u);
            asm volatile("s_waitcnt vmcnt(0)" ::: "memory");
        } else {
            XB_SPIN(xb_ld(&bar[XB_XGEN(b.x)]) == gen, bar);
            __builtin_amdgcn_fence(__ATOMIC_ACQUIRE, "agent");
            asm volatile("s_waitcnt vmcnt(0)" ::: "memory");
        }
    }
    __syncthreads();
}

struct Args { const float* in[19]; float* out; unsigned char* ws; int ph_lo, ph_hi, li, pad; };
struct Frame {
    LAS unsigned char* lds; volatile LAS unsigned* MISC; gu32* ctl;
    int tid, lane, wave, vcu, G;
    const __attribute__((address_space(4))) Args* a;
    unsigned char* ws;
};
template <class T> __device__ __forceinline__ T* wsp(const Frame& F, size_t off) { return (T*)(F.ws + off); }

template <class Src> __device__ __forceinline__ void tr_item(const Src& src, bf16_t* WT, int ldt, int nblk, LAS float* scr, int item, int lane) {
    const int kb = item / nblk, nb = item % nblk, k0 = 64 * kb, n0 = 32 * nb;
#pragma unroll 8
    for (int i = 0; i < 32; ++i) { const int kk = 2 * i + (lane >> 5); scr[kk * 33 + (lane & 31)] = src(k0 + kk, n0 + (lane & 31)); }
    LDS_WAIT(); asm volatile("" ::: "memory");
    const int c = lane & 7;
#pragma unroll
    for (int j = 0; j < 4; ++j) { const int n = (lane >> 3) + 8 * j; const LAS float* s = scr + (8 * c) * 33 + n;
        v4u o; o.x = pk2(s[0 * 33], s[1 * 33]); o.y = pk2(s[2 * 33], s[3 * 33]); o.z = pk2(s[4 * 33], s[5 * 33]); o.w = pk2(s[6 * 33], s[7 * 33]);
        *(GAS v4u*)(WT + (size_t)(n0 + n) * ldt + k0 + 8 * c) = o; }
    LDS_WAIT(); asm volatile("" ::: "memory");
}
__device__ __forceinline__ int win_srccol(int n) {
    if (n < 1152) return n; if (n < 2304) return n - 1152 + 1574; if (n < 2560) return n - 2304 + 1158; if (n < 2688) return n - 2560 + 1414;
    if (n < 2720) return n - 2688 + 1542; if (n < 2726) return n - 2720 + 1152; return -1;
}
__device__ __forceinline__ void xn_row(const float* xrow, bf16_t* orow, float* ssq2, int lane) {
    const GAS f32x4* xr = (const GAS f32x4*)xrow + lane;
    f32x4 v[4]; float s = 0.f;
#pragma unroll
    for (int j = 0; j < 4; ++j) { v[j] = __builtin_nontemporal_load(xr + 64 * j); s += (v[j].x * v[j].x + v[j].y * v[j].y) + (v[j].z * v[j].z + v[j].w * v[j].w); }
    s = wave_sum(s);
    if (lane < 8) ssq2[lane] = (lane == 0) ? s : 0.f;
    GAS unsigned long long* o8 = (GAS unsigned long long*)orow + lane;
#pragma unroll
    for (int j = 0; j < 4; ++j) o8[64 * j] = (unsigned long long)pk2(v[j].x, v[j].y) | ((unsigned long long)pk2(v[j].z, v[j].w) << 32);
}
__device__ __forceinline__ void p0_prologue(Frame& F, int parts) {
    LAS float* scr = (LAS float*)(F.lds + F.wave * 16384);
    const int gw = F.vcu * NWAVES + F.wave, NGW = F.G * NWAVES, lane = F.lane;
    const __attribute__((address_space(4))) Args* A = F.a;
    if (parts & 1) {
        constexpr int I_IN = (D / 64) * (NP / 32), I_MLA = (384 / 64) * (1024 / 32), I_OUT = (D / 64) * (D / 32), I_Q = (D / 64) * (2048 / 32);
        constexpr int PER_L = I_IN + I_MLA + I_OUT + I_Q;
        for (int it = gw; it < 2 * PER_L; it += NGW) {
            const int l = it / PER_L; int r = it % PER_L;
            if (r < I_IN) { const float* w = A->in[2] + (size_t)l * D * INC; const float* g = A->in[1] + l * D;
                tr_item([&](int k, int n) { const int sc = win_srccol(n); return sc >= 0 ? w[(size_t)k * INC + sc] * g[k] : 0.f; }, wsp<bf16_t>(F, WS_WIN + l * WIN_L), D, NP / 32, scr, r, lane); continue; }
            r -= I_IN;
            if (r < I_MLA) { const float* wq = A->in[5] + (size_t)l * 256 * 384; const float* qg = A->in[4] + l * 256; const float* wkv = A->in[7] + (size_t)l * 128 * 512; const float* kvg = A->in[6] + l * 128;
                tr_item([&](int k, int n) { float v = 0.f; if (n < 384) { if (k < 256) v = wq[k * 384 + n] * qg[k]; } else if (n < 896) { if (k >= 256) v = wkv[(k - 256) * 512 + (n - 384)] * kvg[k - 256]; } return v; },
                        wsp<bf16_t>(F, WS_WMLA + l * WMLA_L), 384, 1024 / 32, scr, r, lane); continue; }
            r -= I_MLA;
            if (r < I_OUT) { const float* w = A->in[11] + (size_t)l * D * D; const float* g1 = A->in[8] + l * 384; const float* g2 = A->in[9] + l * 256; const float* g3 = A->in[10] + l * 384;
                tr_item([&](int k, int n) { const float g = k < 384 ? g1[k] : (k < 640 ? g2[k - 384] : g3[k - 640]); return w[(size_t)k * D + n] * g; }, wsp<bf16_t>(F, WS_WOUT + l * WOUT_L), D, D / 32, scr, r, lane); continue; }
            r -= I_OUT;
            { const float* w = A->in[13] + (size_t)l * D * 2048; const float* g = A->in[12] + l * D;
              tr_item([&](int k, int n) { return w[(size_t)k * 2048 + n] * g[k]; }, wsp<bf16_t>(F, WS_WQ + l * WQ_L), D, 2048 / 32, scr, r, lane); }
        }
        float* ct = wsp<float>(F, WS_ROPE); float* stb = ct + 2048 * 16;
        { bf16_t* kb = wsp<bf16_t>(F, WS_KEYS);
          for (int i = gw * 64 + lane; i < 2 * 65536; i += NGW * 64) { const int l = i >> 16, row = (i >> 8) & 255, d = i & 255, b = row >> 5, rho = row & 31, side = (rho >> 2) & 1, key = 16 * b + 4 * (rho >> 3) + (rho & 3);
              const int ks = d >> 4, hi = (d >> 3) & 1, jj = d & 7;
              kb[(size_t)l * 65536 + (size_t)(((b * 16 + ks) * 64 + hi * 32 + rho) * 8 + jj)] = ((d >> 7) == side) ? (bf16_t)f2bf(A->in[14 + side][(size_t)l * 16384 + key * 128 + (d & 127)]) : (bf16_t)0; } }
        for (int i = gw * 64 + lane; i < 2048 * 16; i += NGW * 64) { const int pos = i >> 4, j = i & 15; const float inv = 1.0f / powf(10000.0f, (float)j / 16.0f); const float ang = (float)pos * inv; ct[i] = cosf(ang); stb[i] = sinf(ang); }
    }
    if ((parts & 2) && !MK_CONVQ) {
        const size_t n16 = (size_t)2 * 16384 * D / 16;
        for (int t = 0; t < 2; ++t) {
            const GAS f32x4* src = (const GAS f32x4*)A->in[16 + t]; GAS v4u* dst = (GAS v4u*)(F.ws + (t ? WS_VB : WS_UB)); const float sc = t ? 8.0f : 64.0f;
            for (size_t i = (size_t)gw * 64 + lane; i < n16; i += (size_t)NGW * 64) { v4u o;
#pragma unroll
                for (int j = 0; j < 4; ++j) { const f32x4 x = src[4 * i + j] * sc; int w = __builtin_amdgcn_cvt_pk_fp8_f32(x[0], x[1], 0, false); w = __builtin_amdgcn_cvt_pk_fp8_f32(x[2], x[3], w, true); o[j] = (unsigned)w; }
                if (MK_UEXP && t == 0) dst[i] = o;
                else { const size_t rr = i >> 6, g16 = i & 63, l2 = rr >> 14, r = rr & 16383; dst[((l2 * 8 + (g16 >> 3)) * 16384 + r) * 8 + (g16 & 7)] = o; } }
        }
    }
    if (parts & 4) { const float* xsrc = (parts & 8) ? wsp<float>(F, WS_X2) : A->in[0]; for (int m = gw; m < M; m += NGW) xn_row(xsrc + (size_t)m * D, wsp<bf16_t>(F, WS_XN) + (size_t)m * D, wsp<float>(F, WS_SSQ2) + (size_t)m * 8, lane); }
}

struct EpiG1 {
    static constexpr bool PERM = true, AFTER_DRAIN = false, HAS_MID = false; static constexpr int MID0 = -1, MID1 = -1;
    bf16_t* P; float* flog; float* ssqq; float* ssqkv; const float* ssq2;
    __device__ __forceinline__ void mid(f32x4 (&)[2][2][4][2], int, int, int) const {}
    __device__ __forceinline__ void operator()(const f32x4 (&acc)[2][2][4][2], const pg8::Unit& u, int wr, int wc, int fr, int fq) const {
        const int row0 = u.pm * 256 + wr * 64 + fr, col0 = u.pn * 256 + wc * 32 + 8 * fq;
        const bool want_sq = (u.pn == 9 || u.pn == 10);
        float rsxv[8];
#pragma unroll
        for (int it = 0; it < 8; ++it) { const int row = row0 + (it >> 2) * 128 + (it & 3) * 16;
            const f32x4 qa_ = *(const GAS f32x4*)(ssq2 + (size_t)row * 8), qb_ = *(const GAS f32x4*)(ssq2 + (size_t)row * 8 + 4);
            rsxv[it] = 1.0f / sqrtf((((qa_[0] + qa_[1]) + (qa_[2] + qa_[3])) + ((qb_[0] + qb_[1]) + (qb_[2] + qb_[3]))) * (1.f / D) + EPS); }
#pragma unroll
        for (int ai = 0; ai < 2; ++ai)
#pragma unroll
            for (int m = 0; m < 4; ++m) { const int row = row0 + ai * 128 + m * 16; bf16_t* rowp = P + (size_t)row * NP + col0; float sq = 0.f;
                const float rsx = rsxv[ai * 4 + m];
#pragma unroll
                for (int bj = 0; bj < 2; ++bj) { const int colg = u.pn * 256 + bj * 128; const float sc = (colg < 384 || (colg >= 1152 && colg < 1536)) ? C2 : 1.0f;
                    const f32x4 v0 = acc[ai][bj][m][0] * rsx, v1 = acc[ai][bj][m][1] * rsx;
                    if (u.pn == 9 || (u.pn == 10 && bj == 0)) sq += (v0[0] * v0[0] + v0[1] * v0[1]) + (v0[2] * v0[2] + v0[3] * v0[3]) + (v1[0] * v1[0] + v1[1] * v1[1]) + (v1[2] * v1[2] + v1[3] * v1[3]);
                    u32x4 w; w.x = cvt_pk(v0[0] * sc, v0[1] * sc); w.y = cvt_pk(v0[2] * sc, v0[3] * sc); w.z = cvt_pk(v1[0] * sc, v1[1] * sc); w.w = cvt_pk(v1[2] * sc, v1[3] * sc);
                    *(u32x4*)(rowp + bj * 128) = w; }
                if (want_sq) { sq += __shfl_xor(sq, 16); sq += __shfl_xor(sq, 32); if (fq == 0) (u.pn == 9 ? ssqq : ssqkv)[(size_t)row * 4 + wc] = sq; }
                if (u.pn == 10 && wc == 1 && fq == 0) { *(f32x4*)(flog + (size_t)row * 8) = acc[ai][1][m][0] * rsx; *(f32x4*)(flog + (size_t)row * 8 + 4) = acc[ai][1][m][1] * rsx; }
            }
    }
};
struct EpiMla {
    static constexpr bool PERM = false, AFTER_DRAIN = true, HAS_MID = false; static constexpr int MID0 = -1, MID1 = -1;
    bf16_t* QUP; bf16_t* KVUP; const float* ssqq; const float* ssqkv; const float* ct; const float* st; const LAS float* fac;
    __device__ __forceinline__ void rs_prelude(const pg8::Unit& u, int tid, LAS float* f) const {
        if (tid < 256) { const int row = u.pm * 256 + tid; const f32x4 sq4 = *(const f32x4*)(ssqq + (size_t)row * 4), sk4 = *(const f32x4*)(ssqkv + (size_t)row * 4);
            f[tid] = C2M / sqrtf(((sq4[0] + sq4[1]) + (sq4[2] + sq4[3])) * (1.f / 256.f) + EPS); f[256 + tid] = 1.0f / sqrtf(((sk4[0] + sk4[1]) + (sk4[2] + sk4[3])) * (1.f / 128.f) + EPS); }
    }
    __device__ __forceinline__ void mid(f32x4 (&)[2][2][4][2], int, int, int) const {}
    __device__ __forceinline__ void fused(const f32x4 (&acc)[2][2][4][2], const pg8::Unit& u, int wr, int wc, int fr, int fq, PG8_LAS unsigned char*, int, int) const { (*this)(acc, u, wr, wc, fr, fq); }
    __device__ __forceinline__ void operator()(const f32x4 (&acc)[2][2][4][2], const pg8::Unit& u, int wr, int wc, int fr, int fq) const {
        const int row0 = u.pm * 256 + wr * 64 + fr;
        const int g0_ = u.pn * 8 + wc, g1_ = g0_ + 4; const bool rope = (g0_ < 12 && g0_ % 3 == 2) || (g1_ < 12 && g1_ % 3 == 2);
#pragma unroll
        for (int ai = 0; ai < 2; ++ai) {
            f32x4 csv[4], snv[4];
            if (rope) {
#pragma unroll
                for (int m = 0; m < 4; ++m) { const int pos = (row0 + ai * 128 + m * 16) & (S - 1); csv[m] = *(const GAS f32x4*)(ct + pos * 16 + 4 * fq); snv[m] = *(const GAS f32x4*)(st + pos * 16 + 4 * fq); } }
#pragma unroll
            for (int m = 0; m < 4; ++m) { asm volatile("" ::: "memory"); const int row = row0 + ai * 128 + m * 16;
                const int rl = ai * 128 + wr * 64 + m * 16 + fr; const float rsq = fac[rl], rskv = fac[256 + rl];
#pragma unroll
                for (int bj = 0; bj < 2; ++bj) { const int g = u.pn * 8 + bj * 4 + wc;
                    f32x4 x0 = acc[ai][bj][m][0], x1 = acc[ai][bj][m][1];
                    if (g < 12) {
                        x0 = x0 * rsq; x1 = x1 * rsq;
                        if (g % 3 == 2) { const f32x4 cs = csv[m], sn = snv[m]; const f32x4 r0 = x0 * cs - x1 * sn, r1 = x0 * sn + x1 * cs; x0 = r0; x1 = r1; }
                        bf16_t* p = QUP + (size_t)row * 384 + g * 32 + 4 * fq;
                        u32x2 w0, w1; w0.x = cvt_pk(x0[0], x0[1]); w0.y = cvt_pk(x0[2], x0[3]); w1.x = cvt_pk(x1[0], x1[1]); w1.y = cvt_pk(x1[2], x1[3]);
                        *(u32x2*)p = w0; *(u32x2*)(p + 16) = w1;
                    } else if (g < 28) {
                        x0 = x0 * rskv; x1 = x1 * rskv;
                        bf16_t* p = KVUP + (size_t)row * 512 + (g - 12) * 32 + 4 * fq;
                        u32x2 w0, w1; w0.x = cvt_pk(x0[0], x0[1]); w0.y = cvt_pk(x0[2], x0[3]); w1.x = cvt_pk(x1[0], x1[1]); w1.y = cvt_pk(x1[2], x1[3]);
                        *(u32x2*)p = w0; *(u32x2*)(p + 16) = w1;
                    }
                }
            }
        }
    }
};
struct EpiWout {
    static constexpr bool PERM = false, AFTER_DRAIN = true, HAS_MID = true; static constexpr int MID0 = 6, MID1 = 10;
    const LAS float* fac;
    const bf16_t* xres; bf16_t* X1B; float* ssqx;
    __device__ __forceinline__ void fused(const f32x4 (&acc)[2][2][4][2], const pg8::Unit& u, int wr, int wc, int fr, int fq, PG8_LAS unsigned char*, int, int) const { (*this)(acc, u, wr, wc, fr, fq); }
    __device__ __forceinline__ void mid(f32x4 (&acc)[2][2][4][2], int t, int wr, int fr) const {
        const int seg = (t == MID0) ? 0 : 1;
#pragma unroll
        for (int ai = 0; ai < 2; ++ai)
#pragma unroll
            for (int m = 0; m < 4; ++m) { const float f = fac[seg * 256 + ai * 128 + wr * 64 + m * 16 + fr];
#pragma unroll
                for (int bj = 0; bj < 2; ++bj)
#pragma unroll
                    for (int n = 0; n < 2; ++n) acc[ai][bj][m][n] = acc[ai][bj][m][n] * f; }
    }
    __device__ __forceinline__ void operator()(const f32x4 (&acc)[2][2][4][2], const pg8::Unit& u, int wr, int wc, int fr, int fq) const {
        const int col0 = u.pn * 256 + wc * 32 + 4 * fq;
        u32x2 xr[4][4];
#define EW_LD(it_) do { const int row_ = u.pm * 256 + ((it_) >> 2) * 128 + wr * 64 + ((it_) & 3) * 16 + fr; \
            _Pragma("unroll") for (int q_ = 0; q_ < 4; ++q_) xr[(it_) & 3][q_] = *(const u32x2*)(xres + (size_t)row_ * D + col0 + (q_ >> 1) * 128 + (q_ & 1) * 16); } while (0)
        EW_LD(0); EW_LD(1); EW_LD(2);
#pragma unroll
        for (int it = 0; it < 8; ++it) { if (it + 3 < 8) EW_LD(it + 3);
            asm volatile("" ::: "memory"); const int ai = it >> 2, m = it & 3; const int rl = ai * 128 + wr * 64 + m * 16 + fr, row = u.pm * 256 + rl; const float f = fac[2 * 256 + rl]; float sq = 0.f;
#pragma unroll
            for (int bj = 0; bj < 2; ++bj)
#pragma unroll
                for (int n = 0; n < 2; ++n) { const size_t off = (size_t)row * D + col0 + bj * 128 + n * 16; const u32x2 xv = xr[it & 3][bj * 2 + n];
                    const f32x4 xf = (f32x4){__builtin_bit_cast(float, xv.x << 16), __builtin_bit_cast(float, xv.x & 0xffff0000u), __builtin_bit_cast(float, xv.y << 16), __builtin_bit_cast(float, xv.y & 0xffff0000u)};
                    const f32x4 v = acc[ai][bj][m][n] * f + xf;
                    u32x2 w; w.x = cvt_pk(v[0], v[1]); w.y = cvt_pk(v[2], v[3]); *(u32x2*)(X1B + off) = w;
                    sq += (v[0] * v[0] + v[1] * v[1]) + (v[2] * v[2] + v[3] * v[3]); }
            sq += __shfl_xor(sq, 16); sq += __shfl_xor(sq, 32);
            if (fq == 0) ssqx[(size_t)row * 16 + u.pn * 4 + wc] = sq; }
#undef EW_LD
    }
};
#ifndef MK_DBGSCORE
#define MK_DBGSCORE 0
#endif
#ifndef MK_DBGREV
#define MK_DBGREV 0
#endif
#ifndef MK_DBGONES
#define MK_DBGONES 0
#endif
#ifndef MK_VALUSCORE
#define MK_VALUSCORE 0
#endif
#ifndef MK_DBGSYN
#define MK_DBGSYN 0
#endif
#ifndef MK_DBGLIST
#define MK_DBGLIST 0
#endif
#ifndef MK_DBGQ
#define MK_DBGQ 0
#endif
__device__ __forceinline__ int crow(int r, int hi);
__device__ __forceinline__ unsigned fbits(float x) { return __builtin_bit_cast(unsigned, x); }
template <bool DESC> __device__ __forceinline__ void ce_(unsigned& x, unsigned& y) { const unsigned hi = x > y ? x : y, lo = x > y ? y : x; if (DESC) { x = hi; y = lo; } else { x = lo; y = hi; } }
template <bool DESC, int OFF, int N> __device__ __forceinline__ void bsort16(unsigned (&a)[N]) {
#pragma unroll
    for (int k = 2; k <= 16; k <<= 1)
#pragma unroll
        for (int j = k >> 1; j > 0; j >>= 1)
#pragma unroll
            for (int i = 0; i < 16; ++i) { const int l = i ^ j; if (l > i) { const bool up = ((i & k) == 0) || (k == 16); if (up) ce_<DESC>(a[OFF + i], a[OFF + l]); else ce_<!DESC>(a[OFF + i], a[OFF + l]); } }
}
template <bool DESC, int OFF, int N> __device__ __forceinline__ void bmerge16(unsigned (&a)[N]) {
#pragma unroll
    for (int j = 8; j > 0; j >>= 1)
#pragma unroll
        for (int i = 0; i < 16; ++i) { const int l = i ^ j; if (l > i) ce_<DESC>(a[OFF + i], a[OFF + l]); }
}
__device__ __forceinline__ void top16_of_64(unsigned (&a)[64]) {
    bsort16<true, 0>(a); bsort16<false, 16>(a); bsort16<true, 32>(a); bsort16<false, 48>(a);
#pragma unroll
    for (int i = 0; i < 16; ++i) { a[i] = a[i] > a[16 + i] ? a[i] : a[16 + i]; a[32 + i] = a[32 + i] > a[48 + i] ? a[32 + i] : a[48 + i]; }
    bmerge16<true, 0>(a); bmerge16<false, 32>(a);
#pragma unroll
    for (int i = 0; i < 16; ++i) a[i] = a[i] > a[32 + i] ? a[i] : a[32 + i];
    bmerge16<true, 0>(a);
}
__device__ __forceinline__ int key_index(unsigned k) { const unsigned c = k & 127u, hs = (c >> 6) & 1u, l6 = 63u - (c & 63u), blk = l6 >> 4, r = l6 & 15u; return (int)(32u * blk + (r & 3u) + 8u * (r >> 2) + 4u * hs); }
typedef float f32x16q __attribute__((ext_vector_type(16)));
struct EpiQ {
    static constexpr bool PERM = false, AFTER_DRAIN = true, HAS_MID = false; static constexpr int MID0 = -1, MID1 = -1;
    const float* ssqx; const bf16_t* keys;
    unsigned short* ids; float* gates; float* Qdbg; float* rsx; const LAS float* fac;
    __device__ __forceinline__ void rs_prelude(const pg8::Unit& u, int tid, LAS float* f) const {
        if (tid < 256) { const int row = u.pm * 256 + tid; const float* sp = ssqx + (size_t)row * 16;
            const f32x4 a = *(const f32x4*)sp, b = *(const f32x4*)(sp + 4), c = *(const f32x4*)(sp + 8), d = *(const f32x4*)(sp + 12);
            const float ss = ((a[0] + a[1]) + (a[2] + a[3])) + ((b[0] + b[1]) + (b[2] + b[3])) + ((c[0] + c[1]) + (c[2] + c[3])) + ((d[0] + d[1]) + (d[2] + d[3]));
            const float rs = 1.0f / sqrtf(ss * (1.f / D) + EPS);
            f[tid] = rs; if (u.pn == 0) rsx[row] = rs; }
    }
    __device__ __forceinline__ void mid(f32x4 (&)[2][2][4][2], int, int, int) const {}
    __device__ __forceinline__ void fused(const f32x4 (&acc)[2][2][4][2], const pg8::Unit& u, int wr, int wc, int fr, int fq, PG8_LAS unsigned char* lds, int wid, int lane) const {
#pragma unroll
        for (int ai = 0; ai < 2; ++ai)
#pragma unroll
            for (int m = 0; m < 4; ++m) { asm volatile("" ::: "memory"); const int rl = ai * 128 + wr * 64 + m * 16 + fr, row = u.pm * 256 + rl;
                const float rs = fac[rl];
#pragma unroll
                for (int bj = 0; bj < 2; ++bj)
#pragma unroll
                    for (int n = 0; n < 2; ++n) { const f32x4 v = acc[ai][bj][m][n] * rs; const int ch = 16 * bj + 4 * wc + 2 * n + (fq >> 1);
                        if (Qdbg && MK_DBGQ != 2) *(f32x4*)(Qdbg + (size_t)row * 2048 + u.pn * 256 + bj * 128 + wc * 32 + n * 16 + 4 * fq) = v;
                        u32x2 w; w.x = cvt_pk(v[0], v[1]); w.y = cvt_pk(v[2], v[3]);
                        *(PG8_LAS u32x2*)(lds + rl * 512 + ((ch ^ (rl & 15)) << 4) + (fq & 1) * 8) = w; } }
        asm volatile("s_waitcnt lgkmcnt(0)\n\ts_barrier" ::: "memory");
        const int r32 = lane & 31, hi = lane >> 5, tl = wid * 32 + r32;
        unsigned lst[16]; unsigned dbgS[16]; float dbgF[16];
#if MK_DBGLIST == 11
        { float hs = 0.f;
#pragma unroll
          for (int ks = 0; ks < 16; ++ks) { const bf16x8 kv = *(const bf16x8*)(keys + (size_t)r32 * 256 + 16 * ks + 8 * hi);
#pragma unroll
              for (int e = 0; e < 8; ++e) hs += __builtin_bit_cast(float, (unsigned)(unsigned short)kv[e] << 16); }
          auto rr = __builtin_amdgcn_permlane32_swap(__float_as_uint(hs), __float_as_uint(hs), false, false); const float tot = __uint_as_float(rr[0]) + __uint_as_float(rr[1]) + 32.0f;
#pragma unroll
          for (int k = 0; k < 16; ++k) dbgS[k] = __builtin_bit_cast(unsigned, tot); }
#endif
        bf16x8 ka[16];
        { const bf16_t* kr0 = keys + (size_t)lane * 8;
#pragma unroll
          for (int ks = 0; ks < 16; ++ks) ka[ks] = *(const bf16x8*)(kr0 + ks * 512); }
#pragma unroll 1
        for (int b = 0; b < 8; ++b) {
            f32x16q s0;
#pragma unroll
            for (int r = 0; r < 16; ++r) s0[r] = 32.0f;
            asm volatile("" : "+v"(s0));
#pragma unroll
            for (int ks = 0; ks < 16; ++ks) { const bf16x8 bq = *(const PG8_LAS bf16x8*)(lds + tl * 512 + (((2 * ks + hi) ^ (tl & 15)) << 4));
                s0 = __builtin_amdgcn_mfma_f32_32x32x16_bf16(ka[ks], bq, s0, 0, 0, 0); }
            { const bf16_t* kr = keys + (size_t)(b < 7 ? b + 1 : 7) * 8192 + (size_t)lane * 8;
#pragma unroll
              for (int ks = 0; ks < 16; ++ks) ka[ks] = *(const bf16x8*)(kr + ks * 512); }
#if MK_DBGLIST == 8
            if (b == 0) {
#pragma unroll
                for (int r = 0; r < 16; ++r) dbgS[r] = fbits(s0[r]); }
#endif
            unsigned nw[16];
#pragma unroll
            for (int r = 0; r < 16; ++r) nw[r] = (fbits(s0[r]) & ~127u) | ((unsigned)(127 - r) - (unsigned)(16 * b));
            bsort16<false, 0>(nw);
            if (b == 0) {
#pragma unroll
                for (int i = 0; i < 16; ++i) lst[i] = nw[15 - i];
            } else {
#pragma unroll
                for (int i = 0; i < 16; ++i) lst[i] = lst[i] > nw[i] ? lst[i] : nw[i];
                bmerge16<true, 0>(lst);
            }
        }
#if MK_DBGLIST == 9
        { float sv[16];
#pragma unroll
          for (int k = 0; k < 16; ++k) sv[k] = 32.0f;
#pragma unroll 1
          for (int c = 0; c < 16; ++c) { const u32x4 qv = *(const PG8_LAS u32x4*)(lds + tl * 512 + ((c ^ (tl & 15)) << 4));
#pragma unroll
              for (int k = 0; k < 16; ++k) { const u32x4 kv = *(const u32x4*)(keys + (size_t)(8 * (k >> 2) + (k & 3)) * 256 + 8 * c); float s = sv[k];
#pragma unroll
                  for (int e = 0; e < 4; ++e) { s = fmaf(__builtin_bit_cast(float, qv[e] << 16), __builtin_bit_cast(float, kv[e] << 16), s); s = fmaf(__builtin_bit_cast(float, qv[e] & 0xffff0000u), __builtin_bit_cast(float, kv[e] & 0xffff0000u), s); }
                  sv[k] = s; } }
#pragma unroll
          for (int k = 0; k < 16; ++k) dbgS[k] = __builtin_bit_cast(unsigned, sv[k]); }
#endif
        asm volatile("s_waitcnt lgkmcnt(0)\n\ts_barrier" ::: "memory");
        PG8_LAS unsigned* tk = (PG8_LAS unsigned*)(lds + wid * (32 * 36 * 4)) + r32 * 36;
#pragma unroll
        for (int i4 = 0; i4 < 4; ++i4) *(PG8_LAS u32x4*)(tk + 16 * hi + 4 * i4) = (u32x4){lst[4 * i4], lst[4 * i4 + 1], lst[4 * i4 + 2], lst[4 * i4 + 3]};
        asm volatile("s_waitcnt lgkmcnt(0)" ::: "memory");
        unsigned s1k[16], s2k[16];
#pragma unroll
        for (int i4 = 0; i4 < 4; ++i4) { const u32x4 x = *(const PG8_LAS u32x4*)(tk + 4 * i4), y = *(const PG8_LAS u32x4*)(tk + 16 + 4 * i4);
#pragma unroll
            for (int e = 0; e < 4; ++e) { s1k[4 * i4 + e] = x[e]; s2k[4 * i4 + e] = y[e]; } }
        unsigned cd[64];
        { int n = 0;
#pragma unroll
          for (int i = 0; i < 16; ++i)
#pragma unroll
              for (int j = 0; j < 16; ++j) if ((i + 1) * (j + 1) <= 16) { const float s = __builtin_bit_cast(float, s1k[i] & ~127u) + __builtin_bit_cast(float, s2k[j] & ~127u);
                  cd[n] = (__builtin_bit_cast(unsigned, s) & ~255u) | (unsigned)(255 - (16 * i + j)); ++n; }
#pragma unroll
          for (int i = 50; i < 64; ++i) cd[i] = 0u; }
        top16_of_64(cd);
        float val[16]; int eid[16]; float mx = -INFINITY;
#pragma unroll
        for (int k = 0; k < 16; ++k) { const unsigned code = 255u - (cd[k] & 255u), i = code >> 4, j = code & 15u; const unsigned k1 = tk[i], k2 = tk[16 + j];
            val[k] = __builtin_bit_cast(float, k1 & ~127u) + __builtin_bit_cast(float, k2 & ~127u); eid[k] = (int)(127u - (k1 & 127u)) * 128 + (int)(127u - (k2 & 127u)); mx = fmaxf(mx, val[k]); }
#if MK_DBGLIST == 8 || MK_DBGLIST == 9 || MK_DBGLIST == 11
#pragma unroll
        for (int k = 0; k < 16; ++k) eid[k] = (int)dbgS[k];
#endif
#if MK_DBGLIST == 10
#pragma unroll
        for (int k = 0; k < 16; ++k) eid[k] = __builtin_bit_cast(int, dbgF[k]);
#endif
        float sum = 0.f;
#pragma unroll
        for (int k = 0; k < 16; ++k) { val[k] = __builtin_amdgcn_exp2f((val[k] - mx) * LOG2E); sum += val[k]; }
        const float inv = 1.0f / sum;
        const size_t ob = ((size_t)(u.pm * 256 + tl) * 8 + u.pn) * 16;
        if (hi == 0) {
#pragma unroll
            for (int k4 = 0; k4 < 2; ++k4) *(u32x4*)(ids + ob + 8 * k4) = (u32x4){(unsigned)eid[8 * k4] | ((unsigned)eid[8 * k4 + 1] << 16), (unsigned)eid[8 * k4 + 2] | ((unsigned)eid[8 * k4 + 3] << 16), (unsigned)eid[8 * k4 + 4] | ((unsigned)eid[8 * k4 + 5] << 16), (unsigned)eid[8 * k4 + 6] | ((unsigned)eid[8 * k4 + 7] << 16)};
        } else {
#pragma unroll
            for (int k4 = 0; k4 < 4; ++k4) *(f32x4*)(gates + ob + 4 * k4) = (f32x4){val[4 * k4] * inv, val[4 * k4 + 1] * inv, val[4 * k4 + 2] * inv, val[4 * k4 + 3] * inv};
        }
        asm volatile("s_waitcnt lgkmcnt(0)\n\ts_barrier" ::: "memory");
    }
};
struct OneUnit { pg8::StaticOrder S; int i;
    __device__ __forceinline__ bool next(int j, pg8::Unit& u) const { return j == 0 ? S.next(i, u) : false; }
    __device__ __forceinline__ void a_ready(const pg8::Unit&) const {}
    __device__ __forceinline__ void done(const pg8::Unit&) const {} };
}

namespace fx {
typedef short s16x4 __attribute__((ext_vector_type(4)));
typedef float f32x16 __attribute__((ext_vector_type(16)));
typedef LAS const char* lds_cptr;
typedef short v4i16_t __attribute__((ext_vector_type(4)));
#define AT_MFMA(a, b, c) __builtin_amdgcn_mfma_f32_32x32x16_bf16(a, b, c, 0, 0, 0)
__device__ __forceinline__ int crow(int r, int hi) { return (r & 3) + 8 * (r >> 2) + 4 * hi; }
__device__ __forceinline__ void glds16(const void* gsrc, unsigned lds_dst) { unsigned keep;
    asm volatile("s_mov_b32 %0, m0\n\ts_mov_b32 m0, %2\n\ts_nop 0\n\tglobal_load_lds_dwordx4 %1, off\n\ts_mov_b32 m0, %0" : "=&s"(keep) : "v"(gsrc), "s"(lds_dst) : "memory"); }
__device__ __forceinline__ s16x4 vtr(lds_cptr p) { return __builtin_bit_cast(s16x4, __builtin_amdgcn_ds_read_tr16_b64_v4i16((LAS v4i16_t*)p)); }
__device__ __forceinline__ float swap_sum(float v) { auto rr = __builtin_amdgcn_permlane32_swap(__float_as_uint(v), __float_as_uint(v), false, false); return __uint_as_float(rr[0]) + __uint_as_float(rr[1]); }
__device__ __forceinline__ float swap_max(float v) { auto rr = __builtin_amdgcn_permlane32_swap(__float_as_uint(v), __float_as_uint(v), false, false); return fmaxf(__uint_as_float(rr[0]), __uint_as_float(rr[1])); }

#ifndef MK_ABL
#define MK_ABL 0
#endif
struct AttnP { const bf16_t *Q, *K, *KX, *V; int ldq, ldk, ldkx, ldv; bf16_t* O; float* ssq; int abl; };

constexpr int AT_SLOTV = 8192;
constexpr float AT_THR = 8.0f;
template <int MODE, int NX, int QX>
__device__ __forceinline__ void attn_unit(const AttnP& U, int qb, LAS unsigned char* ldsb) {
    constexpr int ND0 = 4 + NX / 2, KSL = (8 + NX) * 1024, LV0 = 3 * KSL, LWS = LV0 + 3 * AT_SLOTV, LOST = LWS + 8 * 256;
    constexpr int LDONE = LOST + 8 * 4096;
    static_assert(LDONE + 64 <= RING_BYTES, "attention LDS");
    int tid_ = threadIdx.x; asm volatile("" : "+v"(tid_));
    const int tid = tid_, lane = tid & 63, r32 = lane & 31, hi = lane >> 5; const int wid = __builtin_amdgcn_readfirstlane(tid >> 6);
    const int q0 = qb * 256, NT = 4 * qb + 4, tdiag = 4 * qb + (wid >> 1);
    const unsigned lds0 = (unsigned)(uintptr_t)ldsb;
    LAS float* wsf = (LAS float*)(ldsb + LWS) + wid * 64;
    const bf16_t* ksrc = U.K + (size_t)(8 * wid + (lane >> 3)) * U.ldk + (((lane & 7) ^ (((8 * wid + (lane >> 3)) >> 1) & 7)) * 8);
    const bf16_t* kxsrc = (NX > 0) ? U.KX + (size_t)lane * U.ldkx + (wid & 3) * 8 : nullptr;
    const bf16_t* vsrc = U.V + (size_t)(16 * (wid & 3) + (lane >> 2)) * U.ldv + (wid >> 2) * 32 + (lane & 3) * 8;
    const unsigned kdst = lds0 + wid * 1024, kxdst = lds0 + (8 + (wid & 3)) * 1024, vdst = lds0 + LV0 + wid * 1024;
#define AT_DMA(t, s) do { glds16(ksrc + (size_t)(t) * 64 * U.ldk, (unsigned)__builtin_amdgcn_readfirstlane(kdst + (s) * KSL)); \
        if (NX > 0 && wid < NX) glds16(kxsrc + (size_t)(t) * 64 * U.ldkx, (unsigned)__builtin_amdgcn_readfirstlane(kxdst + (s) * KSL)); \
        glds16(vsrc + (size_t)(t) * 64 * U.ldv, (unsigned)__builtin_amdgcn_readfirstlane(vdst + (s) * AT_SLOTV)); } while (0)
#define AT_TILE(i) ((MODE == 0) ? (i) : (NT - 1 - (i)))
    AT_DMA(AT_TILE(0), 0); if (NT > 1) AT_DMA(AT_TILE(1), 1);
    bf16x8 qr[ND0];
    { const bf16_t* Qw = U.Q + (size_t)(q0 + wid * 32 + r32) * U.ldq + hi * 8;
#pragma unroll
      for (int d0 = 0; d0 < 4; ++d0) qr[d0] = *(const bf16x8*)(Qw + d0 * 16);
      if (QX == 2) {
#pragma unroll
          for (int d0 = 4; d0 < ND0; ++d0) qr[d0] = *(const bf16x8*)(Qw + d0 * 16);
      } else if (QX == 1) {
          const short one = (short)0x3F80; qr[4] = (bf16x8){0, 0, 0, 0, 0, 0, 0, 0}; if (hi == 0) { qr[4][0] = one; qr[4][1] = one; }
      } }
#pragma unroll
    for (int d0 = 0; d0 < ND0; ++d0) asm volatile("" : "+v"(qr[d0]));
    f32x16 o[2]; o[0] = f32x16{}; o[1] = f32x16{};
    f32x16 negm = f32x16{};
    float mhat = 0.f, l_reg = 0.f, Rc = 0.f; bool first = true;
    const lds_cptr kp0 = (lds_cptr)ldsb + hi * 1024 + r32 * 16;
    const lds_cptr kpm = (lds_cptr)ldsb + r32 * 128; const int kswz = (r32 >> 1) & 7;
    const lds_cptr vp0 = (lds_cptr)ldsb + LV0 + ((lane >> 4) & 1) * 32 + (lane & 3) * 8 + (4 * hi + ((lane & 15) >> 2)) * 64;
    const int qrel = 32 * (wid & 1) + r32;
    int sl = 0; bool wdone = false;
    volatile LAS int* dstamp = (volatile LAS int*)(ldsb + LDONE);
    if (MODE == 1 && lane == 0) dstamp[wid] = 0x7fffffff;
    for (int i = 0; i < NT; ++i) {
        const int t = AT_TILE(i);
        if (i + 1 < NT) { if (NX > 0 && wid < NX) asm volatile("s_waitcnt vmcnt(3) lgkmcnt(0)\n\ts_barrier" ::: "memory"); else asm volatile("s_waitcnt vmcnt(2) lgkmcnt(0)\n\ts_barrier" ::: "memory"); }
        else asm volatile("s_waitcnt vmcnt(0) lgkmcnt(0)\n\ts_barrier" ::: "memory");
        if (MODE == 1) {
            int mx = dstamp[0];
#pragma unroll
            for (int w = 1; w < 8; ++w) { const int v = dstamp[w]; mx = v > mx ? v : mx; }
            if (mx < i) break; }
        if (i + 2 < NT) { const int s2 = (sl >= 1) ? sl - 1 : 2; AT_DMA(AT_TILE(i + 2), s2); }
        if (t <= tdiag && !(MODE == 1 && wdone)) {
            const lds_cptr kp = kp0 + sl * KSL; const lds_cptr vp = vp0 + sl * AT_SLOTV;
            f32x16 p0, p1;
            if (MODE == 0) { p0 = negm; p1 = negm; } else { p0 = f32x16{}; p1 = f32x16{}; }
#pragma unroll
            for (int d0 = 0; d0 < ND0; ++d0) { if (MK_ABL && U.abl == 3) break;
                const lds_cptr ka_ = (d0 < 4) ? kpm + sl * KSL + (((2 * d0 + hi) ^ kswz) << 4) : kp + d0 * 2048; const int kstep = (d0 < 4) ? 4096 : 512;
                const bf16x8 k0 = *(const LAS bf16x8*)(ka_), k1 = *(const LAS bf16x8*)(ka_ + kstep);
                p0 = AT_MFMA(k0, qr[d0], p0); p1 = AT_MFMA(k1, qr[d0], p1); }
            if (MK_ABL && U.abl == 1) { } else
            if (MODE == 0) {
                if (t == tdiag) {
#pragma unroll
                    for (int r = 0; r < 16; ++r) { const int kv = crow(r, hi); if (kv > qrel) p0[r] = -INFINITY; if (kv + 32 > qrel) p1[r] = -INFINITY; } }
                float rm = fmaxf(p0[0], p1[0]);
#pragma unroll
                for (int r = 1; r < 16; ++r) rm = fmaxf(rm, fmaxf(p0[r], p1[r]));
                rm = swap_max(rm);
                if (first) { mhat = rm;
#pragma unroll
                    for (int r = 0; r < 16; ++r) { p0[r] -= rm; p1[r] -= rm; negm[r] = -mhat; }
                    first = false;
                } else if (__any(rm > AT_THR)) { const float dl = fmaxf(rm, 0.f); mhat += dl;
#pragma unroll
                    for (int r = 0; r < 16; ++r) { p0[r] -= dl; p1[r] -= dl; negm[r] = -mhat; }
                    const float f = __builtin_amdgcn_exp2f(-dl); l_reg *= f; if (hi == 0) wsf[r32] = f;
#pragma unroll
                    for (int g = 0; g < 4; ++g) { const f32x4 fv = *(const LAS f32x4*)(wsf + 8 * g + 4 * hi);
#pragma unroll
                        for (int e = 0; e < 4; ++e) { o[0][4 * g + e] *= fv[e]; o[1][4 * g + e] *= fv[e]; } }
                }
                float sacc = 0.f;
#pragma unroll
                for (int r = 0; r < 16; ++r) { p0[r] = __builtin_amdgcn_exp2f(p0[r]); p1[r] = __builtin_amdgcn_exp2f(p1[r]); sacc += p0[r] + p1[r]; }
                l_reg += sacc;
            } else {
                f32x16 lk0, lk1;
#pragma unroll
                for (int r = 0; r < 16; ++r) {
                    { const float z = p0[r]; const float e = __builtin_amdgcn_exp2f(-fabsf(z)); lk0[r] = -(fmaxf(z, 0.f) + __builtin_amdgcn_logf(1.0f + e)); }
                    { const float z = p1[r]; const float e = __builtin_amdgcn_exp2f(-fabsf(z)); lk1[r] = -(fmaxf(z, 0.f) + __builtin_amdgcn_logf(1.0f + e)); } }
                if (t == tdiag) {
#pragma unroll
                    for (int r = 0; r < 16; ++r) { const int kv = crow(r, hi); if (kv >= qrel) { lk0[r] = 0.f; p0[r] = -INFINITY; } if (kv + 32 >= qrel) { lk1[r] = 0.f; p1[r] = -INFINITY; } } }
                float Bo[8], T[8];
#pragma unroll
                for (int j = 0; j < 4; ++j) { Bo[j] = (lk0[4 * j] + lk0[4 * j + 1]) + (lk0[4 * j + 2] + lk0[4 * j + 3]); Bo[4 + j] = (lk1[4 * j] + lk1[4 * j + 1]) + (lk1[4 * j + 2] + lk1[4 * j + 3]); }
#pragma unroll
                for (int j = 0; j < 8; ++j) T[j] = swap_sum(Bo[j]);
                float sfx = Rc;
#pragma unroll
                for (int j = 7; j >= 0; --j) { float off = sfx + (hi == 0 ? (T[j] - Bo[j]) : 0.f); sfx += T[j];
                    if (j < 4) { float s3 = off, s2 = s3 + lk0[4 * j + 3], s1 = s2 + lk0[4 * j + 2], s0 = s1 + lk0[4 * j + 1];
                        p0[4 * j + 3] = __builtin_amdgcn_exp2f(p0[4 * j + 3] + lk0[4 * j + 3] + s3); p0[4 * j + 2] = __builtin_amdgcn_exp2f(p0[4 * j + 2] + lk0[4 * j + 2] + s2);
                        p0[4 * j + 1] = __builtin_amdgcn_exp2f(p0[4 * j + 1] + lk0[4 * j + 1] + s1); p0[4 * j + 0] = __builtin_amdgcn_exp2f(p0[4 * j + 0] + lk0[4 * j + 0] + s0);
                    } else { const int jj = j - 4; float s3 = off, s2 = s3 + lk1[4 * jj + 3], s1 = s2 + lk1[4 * jj + 2], s0 = s1 + lk1[4 * jj + 1];
                        p1[4 * jj + 3] = __builtin_amdgcn_exp2f(p1[4 * jj + 3] + lk1[4 * jj + 3] + s3); p1[4 * jj + 2] = __builtin_amdgcn_exp2f(p1[4 * jj + 2] + lk1[4 * jj + 2] + s2);
                        p1[4 * jj + 1] = __builtin_amdgcn_exp2f(p1[4 * jj + 1] + lk1[4 * jj + 1] + s1); p1[4 * jj + 0] = __builtin_amdgcn_exp2f(p1[4 * jj + 0] + lk1[4 * jj + 0] + s0); }
                }
                Rc = sfx;
                if (__all(Rc < -150.0f)) { wdone = true; if (lane == 0) dstamp[wid] = i; }
            }
            u32x4 pw[4];
#pragma unroll
            for (int k = 0; k < 2; ++k) { pw[k] = (u32x4){cvt_pk(p0[8 * k], p0[8 * k + 1]), cvt_pk(p0[8 * k + 2], p0[8 * k + 3]), cvt_pk(p0[8 * k + 4], p0[8 * k + 5]), cvt_pk(p0[8 * k + 6], p0[8 * k + 7])};
                pw[2 + k] = (u32x4){cvt_pk(p1[8 * k], p1[8 * k + 1]), cvt_pk(p1[8 * k + 2], p1[8 * k + 3]), cvt_pk(p1[8 * k + 4], p1[8 * k + 5]), cvt_pk(p1[8 * k + 6], p1[8 * k + 7])}; }
#pragma unroll
            for (int dh = 0; dh < 2; ++dh)
#pragma unroll
                for (int ks = 0; ks < 4; ++ks) { if (MK_ABL && U.abl == 2) break; const s16x4 lo = vtr(vp + dh * 4096 + ks * 1024), hh = vtr(vp + dh * 4096 + ks * 1024 + 512);
                    const bf16x8 vf = (bf16x8){lo[0], lo[1], lo[2], lo[3], hh[0], hh[1], hh[2], hh[3]};
                    o[dh] = AT_MFMA(__builtin_bit_cast(bf16x8, pw[ks]), vf, o[dh]); }
        }
        sl = (sl == 2) ? 0 : sl + 1;
    }
    float rli[16];
    if (MODE == 0) { const float lt = swap_sum(l_reg); if (hi == 0) wsf[32 + r32] = lt;
#pragma unroll
        for (int g = 0; g < 4; ++g) { const f32x4 lv = *(const LAS f32x4*)(wsf + 32 + 8 * g + 4 * hi);
#pragma unroll
            for (int e = 0; e < 4; ++e) rli[4 * g + e] = __builtin_amdgcn_rcpf(lv[e]); }
    } else {
#pragma unroll
        for (int r = 0; r < 16; ++r) rli[r] = 1.0f; }
    { LAS bf16_t* stg = (LAS bf16_t*)(ldsb + LOST) + wid * 2048;
#pragma unroll
      for (int r = 0; r < 16; ++r) { const int orow = crow(r, hi);
#pragma unroll
          for (int dh = 0; dh < 2; ++dh) stg[orow * 64 + dh * 32 + r32] = (bf16_t)f2bf(o[dh][r] * rli[r]); }
      bf16_t* Ow = U.O + (size_t)(q0 + wid * 32) * D;
#pragma unroll
      for (int ii = 0; ii < 4; ++ii) { const int row = ii * 8 + (lane >> 3), ch = lane & 7; const u32x4 v = *(const LAS u32x4*)(stg + row * 64 + ch * 8);
          *(u32x4*)(Ow + (size_t)row * D + ch * 8) = v;
          float sq = 0.f;
#pragma unroll
          for (int e = 0; e < 4; ++e) { const float a = __builtin_bit_cast(float, v[e] << 16), b = __builtin_bit_cast(float, v[e] & 0xffff0000u); sq += a * a + b * b; }
          sq += __shfl_xor(sq, 1); sq += __shfl_xor(sq, 2); sq += __shfl_xor(sq, 4);
          if (ch == 0) U.ssq[(size_t)(q0 + wid * 32 + row) * 16] = sq; } }
    asm volatile("s_waitcnt vmcnt(0) lgkmcnt(0)\n\ts_barrier" ::: "memory");
#undef AT_DMA
#undef AT_TILE
}

#ifndef AT_MASK
#define AT_MASK 7
#endif
__device__ __forceinline__ unsigned attn_pop(Frame& F, int qi) {
    if (F.tid == 0) F.MISC[16] = __hip_atomic_fetch_add((unsigned*)(F.ctl + CW_ATTQ + 64 * qi), 1u, RLX_AGENT);
    asm volatile("s_waitcnt vmcnt(0) lgkmcnt(0)\n\ts_barrier" ::: "memory");
    const unsigned u = F.MISC[16];
    asm volatile("s_waitcnt lgkmcnt(0)\n\ts_barrier" ::: "memory");
    return u;
}
#ifndef MK_CONVQ
#define MK_CONVQ 1
#endif
__device__ __forceinline__ void conv_unit(Frame& F, int cu) {
    const int t = cu >> 8, c = cu & 255, lane = F.lane;
    const GAS f32x4* src = (const GAS f32x4*)F.a->in[16 + t]; GAS unsigned* dst = (GAS unsigned*)(F.ws + (t ? WS_VB : WS_UB)); const float sc = t ? 8.0f : 64.0f;
#pragma unroll 1
    for (int rb = 0; rb < 16; rb += 8) {
        f32x4 x[8][4];
#pragma unroll
        for (int q = 0; q < 8; ++q) { const size_t rr = (size_t)c * 128 + F.wave * 16 + rb + q;
#pragma unroll
            for (int j = 0; j < 4; ++j) x[q][j] = __builtin_nontemporal_load(src + rr * 256 + 64 * j + lane); }
#pragma unroll
        for (int q = 0; q < 8; ++q) { const size_t rr = (size_t)c * 128 + F.wave * 16 + rb + q, l2 = rr >> 14, r = rr & 16383;
#pragma unroll
            for (int j = 0; j < 4; ++j) { const f32x4 v = x[q][j] * sc; int w = __builtin_amdgcn_cvt_pk_fp8_f32(v[0], v[1], 0, false); w = __builtin_amdgcn_cvt_pk_fp8_f32(v[2], v[3], w, true);
                dst[((l2 * 8 + 2 * j + (lane >> 5)) * 16384 + r) * 32 + (lane & 31)] = (unsigned)w; } }
    }
}
__device__ __forceinline__ void attn_phase(Frame& F, int l) {
    const int tmask = ((F.a->pad >> 4) & 7) ? ((F.a->pad >> 4) & 7) : 7;
    const bool conv = MK_CONVQ && l == 0;
    const unsigned NTOT = conv ? 1536u : 1024u;
    for (;;) {
        const unsigned u = attn_pop(F, l * 3 + 1); if (u >= NTOT) break;
        unsigned a = u;
        if (conv) { if (u % 3u == 2u) { conv_unit(F, (int)(u / 3u)); continue; } a = 2u * (u / 3u) + u % 3u; }
        if (a < 640u) {
            const int qb = 7 - (int)(a / 80u), r = (int)(a % 80u);
            if (r < 32) {
                if (!((AT_MASK & 4) && (tmask & 4))) continue;
                const int b = r / 4, h = r % 4; const size_t r0 = (size_t)b * S;
                AttnP P;
                P.Q = wsp<bf16_t>(F, WS_QUP) + r0 * 384 + 96 * h; P.ldq = 384; P.K = wsp<bf16_t>(F, WS_KVUP) + r0 * 512 + 128 * h; P.V = P.K + 64; P.ldk = P.ldv = 512;
                P.KX = wsp<bf16_t>(F, WS_KR) + r0 * 32; P.ldkx = 32;
                P.O = wsp<bf16_t>(F, WS_Y) + r0 * D + 384 + 64 * h; P.ssq = wsp<float>(F, WS_SSQH) + r0 * 16 + 6 + h;
                P.abl = (F.a->pad >> 8) & 7; if (MK_ABL && ((F.a->pad >> 7) & 1)) { P.O = wsp<bf16_t>(F, WS_PART) + r0 * D + 384 + 64 * h; P.ssq = wsp<float>(F, WS_PART + 64 * MiB) + r0 * 16 + 6 + h; }
                attn_unit<0, 4, 2>(P, qb, F.lds);
            } else {
                if (!((AT_MASK & 2) && (tmask & 2))) continue;
                const int idx = r - 32, b = idx / 6, h = idx % 6; const size_t r0 = (size_t)b * S;
                bf16_t* PROJ = wsp<bf16_t>(F, WS_PROJ); AttnP P;
                P.Q = PROJ + r0 * NP + PC_FQ + 64 * h; P.K = PROJ + r0 * NP + PC_FK + 64 * h; P.V = PROJ + r0 * NP + PC_FV + 64 * h; P.ldq = P.ldk = P.ldv = NP;
                P.KX = wsp<bf16_t>(F, WS_KEXT) + r0 * 96 + 16 * h; P.ldkx = 96;
                P.O = wsp<bf16_t>(F, WS_Y) + r0 * D + 64 * h; P.ssq = wsp<float>(F, WS_SSQH) + r0 * 16 + h;
                P.abl = (F.a->pad >> 8) & 7; if (MK_ABL && ((F.a->pad >> 7) & 1)) { P.O = wsp<bf16_t>(F, WS_PART) + r0 * D + 64 * h; P.ssq = wsp<float>(F, WS_PART + 64 * MiB) + r0 * 16 + h; }
                attn_unit<0, 2, 1>(P, qb, F.lds);
            }
        } else {
            if (!((AT_MASK & 1) && (tmask & 1))) continue;
            const unsigned v = a - 640u;
            const int qb = 7 - (int)(v / 48u), idx = (int)(v % 48u), b = idx / 6, h = idx % 6; const size_t r0 = (size_t)b * S;
            bf16_t* PROJ = wsp<bf16_t>(F, WS_PROJ); AttnP P;
            P.Q = PROJ + r0 * NP + PC_SQ + 64 * h; P.K = PROJ + r0 * NP + PC_SK + 64 * h; P.V = PROJ + r0 * NP + PC_SV + 64 * h; P.KX = nullptr; P.ldq = P.ldk = P.ldv = NP; P.ldkx = 0;
            P.O = wsp<bf16_t>(F, WS_Y) + r0 * D + 640 + 64 * h; P.ssq = wsp<float>(F, WS_SSQH) + r0 * 16 + 10 + h;
            P.abl = (F.a->pad >> 8) & 7; if (MK_ABL && ((F.a->pad >> 7) & 1)) { P.O = wsp<bf16_t>(F, WS_PART) + r0 * D + 640 + 64 * h; P.ssq = wsp<float>(F, WS_PART + 64 * MiB) + r0 * 16 + 10 + h; }
            attn_unit<1, 0, 0>(P, qb, F.lds);
        }
    }
}

__device__ __forceinline__ float logsig(float x) { return fminf(x, 0.f) - log1pf(expf(-fabsf(x))); }
__device__ __forceinline__ void prep_phase(Frame& F, int l) {
    const int gw = F.vcu * NWAVES + F.wave, NGW = F.G * NWAVES, lane = F.lane;
    const float* flog = wsp<float>(F, WS_FLOG); const float* fb = F.a->in[3] + l * 6; bf16_t* KEXT = wsp<bf16_t>(F, WS_KEXT);
    if (F.wave == 0 && (int)blockIdx.x < B * 6) {
        const int b = (int)blockIdx.x / 6, h = (int)blockIdx.x % 6; const float bias = fb[h]; const size_t r0 = (size_t)b * S + lane * 32;
        float lf[32];
#pragma unroll
        for (int i = 0; i < 32; ++i) lf[i] = flog[(r0 + i) * 8 + h];
        float tot = 0.f;
#pragma unroll
        for (int i = 0; i < 32; ++i) { lf[i] = logsig(lf[i] + bias); tot += lf[i]; }
        float incl = tot;
#pragma unroll
        for (int o = 1; o < 64; o <<= 1) { const float n = __shfl_up(incl, o); if (lane >= o) incl += n; }
        float c = incl - tot;
#pragma unroll
        for (int i = 0; i < 32; ++i) { c += lf[i]; const float val = -c * LOG2E; const unsigned hb = f2bf(val); const float hf = __builtin_bit_cast(float, hb << 16); const unsigned lb = f2bf(val - hf);
            v4u w0 = {hb | (lb << 16), 0u, 0u, 0u}, w1 = {0u, 0u, 0u, 0u}; GAS v4u* dst = (GAS v4u*)(KEXT + (r0 + i) * 96 + 16 * h); dst[0] = w0; dst[1] = w1; }
    }
    const bf16_t* PROJ = wsp<bf16_t>(F, WS_PROJ); bf16_t* KR = wsp<bf16_t>(F, WS_KR); const float* ct = wsp<float>(F, WS_ROPE); const float* st = ct + 2048 * 16;
    for (int i = gw * 64 + lane; i < M * 16; i += NGW * 64) { const int row = i >> 4, j = i & 15, pos = row & (S - 1);
        const float x1 = bf2f(PROJ[(size_t)row * NP + PC_KR + j]), x2 = bf2f(PROJ[(size_t)row * NP + PC_KR + 16 + j]); const float cs = ct[pos * 16 + j], sn = st[pos * 16 + j];
        KR[(size_t)row * 32 + j] = (bf16_t)f2bf(x1 * cs - x2 * sn); KR[(size_t)row * 32 + 16 + j] = (bf16_t)f2bf(x1 * sn + x2 * cs); }
}

__device__ __forceinline__ void route_item(const float* q, const float* keys1, const float* keys2, int* ids, float* gates, int lane) {
    float s1a = 0.f, s1b = 0.f, s2a = 0.f, s2b = 0.f;
    for (int d = 0; d < 128; d += 4) {
        const f32x4 qa = *(const f32x4*)(q + d), qb = *(const f32x4*)(q + 128 + d);
        const f32x4 k1a = *(const f32x4*)(keys1 + lane * 128 + d), k1b = *(const f32x4*)(keys1 + (lane + 64) * 128 + d);
        const f32x4 k2a = *(const f32x4*)(keys2 + lane * 128 + d), k2b = *(const f32x4*)(keys2 + (lane + 64) * 128 + d);
        s1a += qa.x * k1a.x + qa.y * k1a.y + qa.z * k1a.z + qa.w * k1a.w; s1b += qa.x * k1b.x + qa.y * k1b.y + qa.z * k1b.z + qa.w * k1b.w;
        s2a += qb.x * k2a.x + qb.y * k2a.y + qb.z * k2a.z + qb.w * k2a.w; s2b += qb.x * k2b.x + qb.y * k2b.y + qb.z * k2b.z + qb.w * k2b.w;
    }
    float top1 = 0.f, top2 = 0.f; int idx1 = 0, idx2 = 0;
#pragma unroll
    for (int side = 0; side < 2; ++side) {
        float v0 = side ? s2a : s1a, v1 = side ? s2b : s1b; float tp = 0.f; int ti = 0;
        for (int k = 0; k < 16; ++k) {
            float bv; int bi; if (v0 >= v1) { bv = v0; bi = lane; } else { bv = v1; bi = lane + 64; }
#pragma unroll
            for (int o = 32; o >= 1; o >>= 1) { const float ov = __shfl_xor(bv, o); const int oi = __shfl_xor(bi, o); if (ov > bv || (ov == bv && oi < bi)) { bv = ov; bi = oi; } }
            if (lane == k) { tp = bv; ti = bi; }
            if (bi == lane) v0 = -INFINITY; if (bi == lane + 64) v1 = -INFINITY;
        }
        if (side) { top2 = tp; idx2 = ti; } else { top1 = tp; idx1 = ti; }
    }
    const float a = __shfl(top1, lane >> 2); const int ia = __shfl(idx1, lane >> 2);
    float c0, c1, c2, c3; int e0, e1, e2, e3;
    { const int jb = (lane & 3) * 4;
      c0 = a + __shfl(top2, jb + 0); e0 = ia * 128 + __shfl(idx2, jb + 0);
      c1 = a + __shfl(top2, jb + 1); e1 = ia * 128 + __shfl(idx2, jb + 1);
      c2 = a + __shfl(top2, jb + 2); e2 = ia * 128 + __shfl(idx2, jb + 2);
      c3 = a + __shfl(top2, jb + 3); e3 = ia * 128 + __shfl(idx2, jb + 3); }
    float best = 0.f; int bid = 0;
    for (int k = 0; k < 16; ++k) {
        float bv = c0; int bc = lane * 4, be = e0;
        if (c1 > bv) { bv = c1; bc = lane * 4 + 1; be = e1; }
        if (c2 > bv) { bv = c2; bc = lane * 4 + 2; be = e2; }
        if (c3 > bv) { bv = c3; bc = lane * 4 + 3; be = e3; }
#pragma unroll
        for (int o = 32; o >= 1; o >>= 1) { const float ov = __shfl_xor(bv, o); const int oc = __shfl_xor(bc, o), oe = __shfl_xor(be, o); if (ov > bv || (ov == bv && oc < bc)) { bv = ov; bc = oc; be = oe; } }
        if (lane == k) { best = bv; bid = be; }
        if (bc == lane * 4) c0 = -INFINITY; if (bc == lane * 4 + 1) c1 = -INFINITY; if (bc == lane * 4 + 2) c2 = -INFINITY; if (bc == lane * 4 + 3) c3 = -INFINITY;
    }
    const float mx = __shfl(best, 0);
    const float e = (lane < 16) ? expf(best - mx) : 0.f;
    const float sum = wave_sum(e);
    if (lane < 16) { ids[lane] = bid; gates[lane] = e / sum; }
}
__device__ __forceinline__ void route_phase(Frame& F, int l) {
    const int gw = F.vcu * NWAVES + F.wave, NGW = F.G * NWAVES;
    const float* Q = wsp<float>(F, WS_QF); const float* k1 = F.a->in[14] + (size_t)l * 16384; const float* k2 = F.a->in[15] + (size_t)l * 16384;
    int* ids = wsp<int>(F, WS_IDS); float* gates = wsp<float>(F, WS_GATES);
    for (int it = gw; it < M * 8; it += NGW) route_item(Q + (size_t)(it >> 3) * 2048 + (it & 7) * 256, k1, k2, ids + (size_t)it * 16, gates + (size_t)it * 16, F.lane);
}

#ifndef MK_GSLOW
#define MK_GSLOW 0
#endif
template <int N> __device__ __forceinline__ float row_ror_add(float v) { return v + __builtin_bit_cast(float, __builtin_amdgcn_update_dpp(0, __builtin_bit_cast(int, v), 0x120 + N, 0xf, 0xf, false)); }
__device__ __forceinline__ float gelu1(float v) {
    const float av = fabsf(v), t = __builtin_amdgcn_rcpf(av * 0.2316418882f + 1.0f);
    float q = t * 0.5307027145f + (-0.7265760135f); q = q * t + 0.7107068705f; q = q * t + (-0.142248368f); q = q * t + 0.127414796f; q = q * t;
    const float e = __builtin_amdgcn_exp2f((v * v) * (-0.72134752044f)); const float m = v * (q * e); return v < 0.f ? m : v - m;
}
__device__ __forceinline__ void gather_phase(Frame& F, int l) {
    const int gw = F.vcu * NWAVES + F.wave, NGW = F.G * NWAVES, lane = F.lane;
    const float* X1 = F.a->out; const float* g = F.a->in[12] + (size_t)l * D; const float* ssqx = wsp<float>(F, WS_SSQX);
    const int* ids = wsp<int>(F, WS_IDS); const float* gates = wsp<float>(F, WS_GATES);
    const unsigned char* U8 = F.ws + WS_UB + l * UB_L; const unsigned char* V8 = F.ws + WS_VB + l * UB_L;
    const int row = lane >> 4;
    const int esel0 = (row == 0) ? 0 : (row == 1) ? 2 : (row == 2) ? 1 : 3;
    for (int t = gw; t < M; t += NGW) {
        float x[16], h[16], acc[16];
        { const float* xp = X1 + (size_t)t * D + 16 * lane; const f32x4 a0 = *(const f32x4*)xp, a1 = *(const f32x4*)(xp + 4), a2 = *(const f32x4*)(xp + 8), a3 = *(const f32x4*)(xp + 12);
#pragma unroll
          for (int e = 0; e < 4; ++e) { x[e] = a0[e]; x[4 + e] = a1[e]; x[8 + e] = a2[e]; x[12 + e] = a3[e]; } }
        float ss = 0.f;
        { const float* sp = ssqx + (size_t)t * 16; const f32x4 a = *(const f32x4*)sp, b = *(const f32x4*)(sp + 4), c = *(const f32x4*)(sp + 8), d = *(const f32x4*)(sp + 12);
          ss = ((a[0] + a[1]) + (a[2] + a[3])) + ((b[0] + b[1]) + (b[2] + b[3])) + ((c[0] + c[1]) + (c[2] + c[3])) + ((d[0] + d[1]) + (d[2] + d[3])); }
        const float rs = (1.0f / 64.0f) / sqrtf(ss * (1.f / D) + EPS);
        { const float* gp = g + 16 * lane; const f32x4 a0 = *(const f32x4*)gp, a1 = *(const f32x4*)(gp + 4), a2 = *(const f32x4*)(gp + 8), a3 = *(const f32x4*)(gp + 12);
#pragma unroll
          for (int e = 0; e < 4; ++e) { h[e] = x[e] * rs * a0[e]; h[4 + e] = x[4 + e] * rs * a1[e]; h[8 + e] = x[8 + e] * rs * a2[e]; h[12 + e] = x[12 + e] * rs * a3[e]; } }
#pragma unroll
        for (int e = 0; e < 16; ++e) acc[e] = 0.f;
        const int* idp = ids + (size_t)t * 128; const float* gtp = gates + (size_t)t * 128;
#pragma unroll 1
        for (int e0 = 0; e0 < 128; e0 += 8) {
            int id[8]; u32x4 uu[8], vv[8];
#pragma unroll
            for (int j = 0; j < 8; ++j) id[j] = __builtin_amdgcn_readfirstlane(idp[e0 + j]);
#pragma unroll
            for (int j = 0; j < 8; ++j) uu[j] = *(const u32x4*)(U8 + (size_t)id[j] * D + 16 * lane);
#pragma unroll
            for (int j = 0; j < 8; ++j) vv[j] = *(const u32x4*)(V8 + (size_t)id[j] * D + 16 * lane);
            const float g0 = gtp[e0 + esel0] * 0.125f, g1 = gtp[e0 + 4 + esel0] * 0.125f;
            float p[8];
#pragma unroll
            for (int j = 0; j < 8; ++j) { float s = 0.f;
#pragma unroll
                for (int w = 0; w < 4; ++w) { const auto lo = __builtin_amdgcn_cvt_pk_f32_fp8((int)uu[j][w], false), hi2 = __builtin_amdgcn_cvt_pk_f32_fp8((int)uu[j][w], true);
                    s = fmaf(h[4 * w], lo[0], s); s = fmaf(h[4 * w + 1], lo[1], s); s = fmaf(h[4 * w + 2], hi2[0], s); s = fmaf(h[4 * w + 3], hi2[1], s); }
                p[j] = s; }
#if MK_GSLOW
            float av[8];
#pragma unroll
            for (int j = 0; j < 8; ++j) av[j] = gelu1(wave_sum(p[j])) * gtp[e0 + j] * 0.125f;
#else
            float q4[4];
#pragma unroll
            for (int j = 0; j < 4; ++j) { auto rr = __builtin_amdgcn_permlane32_swap(__float_as_uint(p[2 * j]), __float_as_uint(p[2 * j + 1]), false, false); q4[j] = __uint_as_float(rr[0]) + __uint_as_float(rr[1]); }
            float t2[2];
#pragma unroll
            for (int j = 0; j < 2; ++j) { auto rr = __builtin_amdgcn_permlane16_swap(__float_as_uint(q4[2 * j]), __float_as_uint(q4[2 * j + 1]), false, false); t2[j] = __uint_as_float(rr[0]) + __uint_as_float(rr[1]); }
#pragma unroll
            for (int j = 0; j < 2; ++j) { t2[j] = row_ror_add<8>(t2[j]); t2[j] = row_ror_add<4>(t2[j]); t2[j] = row_ror_add<2>(t2[j]); t2[j] = row_ror_add<1>(t2[j]); }
            const float a0v = gelu1(t2[0]) * g0, a1v = gelu1(t2[1]) * g1;
            float av[8];
#define RLF(V, L) __builtin_bit_cast(float, __builtin_amdgcn_readlane(__builtin_bit_cast(int, V), L))
            av[0] = RLF(a0v, 0); av[2] = RLF(a0v, 16); av[1] = RLF(a0v, 32); av[3] = RLF(a0v, 48);
            av[4] = RLF(a1v, 0); av[6] = RLF(a1v, 16); av[5] = RLF(a1v, 32); av[7] = RLF(a1v, 48);
#undef RLF
#endif
#pragma unroll
            for (int j = 0; j < 8; ++j)
#pragma unroll
                for (int w = 0; w < 4; ++w) { const auto lo = __builtin_amdgcn_cvt_pk_f32_fp8((int)vv[j][w], false), hi2 = __builtin_amdgcn_cvt_pk_f32_fp8((int)vv[j][w], true);
                    acc[4 * w] = fmaf(av[j], lo[0], acc[4 * w]); acc[4 * w + 1] = fmaf(av[j], lo[1], acc[4 * w + 1]); acc[4 * w + 2] = fmaf(av[j], hi2[0], acc[4 * w + 2]); acc[4 * w + 3] = fmaf(av[j], hi2[1], acc[4 * w + 3]); }
        }
        float s2 = 0.f;
#pragma unroll
        for (int e = 0; e < 16; ++e) { x[e] += acc[e]; s2 += x[e] * x[e]; }
        const float r2 = 1.0f / sqrtf(wave_sum(s2) * (1.f / D) + EPS);
        if (l == 0) {
            float* X2 = wsp<float>(F, WS_X2) + (size_t)t * D + 16 * lane; bf16_t* XN = wsp<bf16_t>(F, WS_XN) + (size_t)t * D + 16 * lane;
#pragma unroll
            for (int w = 0; w < 4; ++w) *(f32x4*)(X2 + 4 * w) = (f32x4){x[4 * w], x[4 * w + 1], x[4 * w + 2], x[4 * w + 3]};
            *(u32x4*)XN = (u32x4){pk2(x[0] * r2, x[1] * r2), pk2(x[2] * r2, x[3] * r2), pk2(x[4] * r2, x[5] * r2), pk2(x[6] * r2, x[7] * r2)};
            *(u32x4*)(XN + 8) = (u32x4){pk2(x[8] * r2, x[9] * r2), pk2(x[10] * r2, x[11] * r2), pk2(x[12] * r2, x[13] * r2), pk2(x[14] * r2, x[15] * r2)};
        } else {
            const float* fg = F.a->in[18] + 16 * lane; float* O = F.a->out + (size_t)t * D + 16 * lane;
#pragma unroll
            for (int w = 0; w < 4; ++w) { const f32x4 gg = *(const f32x4*)(fg + 4 * w); *(f32x4*)(O + 4 * w) = (f32x4){x[4 * w] * r2 * gg[0], x[4 * w + 1] * r2 * gg[1], x[4 * w + 2] * r2 * gg[2], x[4 * w + 3] * r2 * gg[3]}; }
        }
    }
}

#ifndef MK_XCCJ
#define MK_XCCJ 0
#endif
typedef int v2i32_t __attribute__((ext_vector_type(2)));
template <int CTRL> __device__ __forceinline__ float dpp_mov(float v) { return __builtin_bit_cast(float, __builtin_amdgcn_update_dpp(0, __builtin_bit_cast(int, v), CTRL, 0xf, 0xf, false)); }
template <int CTRL> __device__ __forceinline__ float dpp_add(float v) { return v + __builtin_bit_cast(float, __builtin_amdgcn_update_dpp(0, __builtin_bit_cast(int, v), CTRL, 0xf, 0xf, false)); }
__device__ __forceinline__ void gather_u_phase(Frame& F, int l) {
    const bf16_t* X1Bp = wsp<bf16_t>(F, WS_X1B); const float* rsxp = wsp<float>(F, WS_RSX);
    const int lane = F.lane, j = MK_XCCJ ? (int)(xb_xcc_id() & 7u) : (int)(blockIdx.x & 7), wg = (int)(blockIdx.x >> 3), nwg = F.G >> 3, es = lane >> 3, c = lane & 7;
    const float* X1 = F.a->out; const float* ssqx = wsp<float>(F, WS_SSQX); const int* ids = wsp<int>(F, WS_IDS);
    const unsigned char* U8 = F.ws + WS_UB + l * UB_L + (size_t)j * (16384 * 128) + 16 * c; float* PART = wsp<float>(F, WS_PART) + (size_t)j * M * 128;
    float gsl[16];
    { const float* gp = F.a->in[12] + (size_t)l * D + 128 * j + 16 * c;
#pragma unroll
      for (int w = 0; w < 4; ++w) { const f32x4 gg = *(const f32x4*)(gp + 4 * w); gsl[4 * w] = gg[0]; gsl[4 * w + 1] = gg[1]; gsl[4 * w + 2] = gg[2]; gsl[4 * w + 3] = gg[3]; } }
    const int t0 = wg * NWAVES + F.wave, tstep = nwg * NWAVES, ntok = (M - t0 + tstep - 1) / tstep;
#define GU_IDS(dst, tt) do { _Pragma("unroll") for (int w = 0; w < 4; ++w) dst[w] = *(const u32x4*)(ids + (size_t)(tt) * 128 + 16 * es + 4 * w); } while (0)
#define GU_ROWS(dst, idv_) do { _Pragma("unroll") for (int i = 0; i < 16; ++i) dst[i] = *(const u32x4*)(U8 + (size_t)idv_[i >> 2][i & 3] * 128); } while (0)
    u32x4 idn[4], rA[16], rB[16];
    { u32x4 id0[4]; GU_IDS(id0, t0); GU_ROWS(rA, id0); GU_IDS(idn, (ntok > 1 ? t0 + tstep : t0)); }
#define GU_BODY(CUR, NXT, kk) do { const int t = t0 + (kk) * tstep; \
        GU_ROWS(NXT, idn); \
        { const int t2 = ((kk) + 2 < ntok) ? t + 2 * tstep : t; GU_IDS(idn, t2); } \
        f32x2 h2[8];                                                      \
        { const float rs = rsxp[t] * (1.0f / 64.0f); const bf16_t* xp = X1Bp + (size_t)t * D + 128 * j + 16 * c; const u32x4 xa = *(const u32x4*)xp, xb = *(const u32x4*)(xp + 8); \
          _Pragma("unroll") for (int e2 = 0; e2 < 4; ++e2) { h2[e2] = (f32x2){__builtin_bit_cast(float, xa[e2] << 16) * rs * gsl[2 * e2], __builtin_bit_cast(float, xa[e2] & 0xffff0000u) * rs * gsl[2 * e2 + 1]}; \
                                           h2[4 + e2] = (f32x2){__builtin_bit_cast(float, xb[e2] << 16) * rs * gsl[8 + 2 * e2], __builtin_bit_cast(float, xb[e2] & 0xffff0000u) * rs * gsl[8 + 2 * e2 + 1]}; } } \
        float p[16]; \
        _Pragma("unroll") for (int i = 0; i < 16; ++i) { f32x2 s2 = (f32x2){0.f, 0.f}; \
            _Pragma("unroll") for (int w = 0; w < 4; ++w) { const f32x2 lo = __builtin_amdgcn_cvt_pk_f32_fp8((int)CUR[i][w], false), hi2 = __builtin_amdgcn_cvt_pk_f32_fp8((int)CUR[i][w], true); \
                s2 = __builtin_elementwise_fma(h2[2 * w], lo, s2); s2 = __builtin_elementwise_fma(h2[2 * w + 1], hi2, s2); } \
            float s = s2[0] + s2[1]; \
            s = dpp_add<0x141>(s); s = dpp_add<0xB1>(s); s = dpp_add<0x4E>(s); p[i] = s; } \
        if (c == 0) { float* dst = PART + (size_t)t * 128 + 16 * es; \
            _Pragma("unroll") for (int w = 0; w < 4; ++w) *(f32x4*)(dst + 4 * w) = (f32x4){p[4 * w], p[4 * w + 1], p[4 * w + 2], p[4 * w + 3]}; } } while (0)
#pragma unroll 1
    for (int k = 0; k < ntok; k += 2) { GU_BODY(rA, rB, k); if (k + 1 < ntok) GU_BODY(rB, rA, k + 1); }
#undef GU_BODY
#undef GU_IDS
#undef GU_ROWS
}
#ifndef MK_UMFMA
#define MK_UMFMA 1
#endif
#ifndef MK_VMFMA
#define MK_VMFMA 1
#endif
#ifndef MK_VTRDBG
#define MK_VTRDBG 1
#endif
__device__ __forceinline__ void xq_pass(Frame& F, int l) {
    const int gw = F.vcu * NWAVES + F.wave, NGW = F.G * NWAVES, lane = F.lane;
    const bf16_t* X1B = wsp<bf16_t>(F, WS_X1B); const float* ssqx = wsp<float>(F, WS_SSQX); unsigned char* XQ = F.ws + WS_XQ;
    float g[16];
    { const float* gp = F.a->in[12] + (size_t)l * D + 16 * lane;
#pragma unroll
      for (int w = 0; w < 4; ++w) { const f32x4 gg = *(const f32x4*)(gp + 4 * w); g[4 * w] = gg[0] * 8.0f; g[4 * w + 1] = gg[1] * 8.0f; g[4 * w + 2] = gg[2] * 8.0f; g[4 * w + 3] = gg[3] * 8.0f; } }
    for (int m0 = gw; m0 < M; m0 += 4 * NGW) {
        u32x4 xa[4], xb[4]; f32x4 sa[4][4];
#pragma unroll
        for (int q = 0; q < 4; ++q) { const int m = m0 + q * NGW; if (m < M) { const bf16_t* xp = X1B + (size_t)m * D + 16 * lane; xa[q] = *(const u32x4*)xp; xb[q] = *(const u32x4*)(xp + 8);
#pragma unroll
            for (int w = 0; w < 4; ++w) sa[q][w] = *(const f32x4*)(ssqx + (size_t)m * 16 + 4 * w); } }
#pragma unroll
        for (int q = 0; q < 4; ++q) { const int m = m0 + q * NGW; if (m < M) {
            const f32x4 a = sa[q][0], b2 = sa[q][1], c2 = sa[q][2], d2 = sa[q][3];
            const float ss = ((a[0] + a[1]) + (a[2] + a[3])) + ((b2[0] + b2[1]) + (b2[2] + b2[3])) + ((c2[0] + c2[1]) + (c2[2] + c2[3])) + ((d2[0] + d2[1]) + (d2[2] + d2[3]));
            const float rs = 1.0f / sqrtf(ss * (1.f / D) + EPS);
            float h[16];
#pragma unroll
            for (int e2 = 0; e2 < 4; ++e2) { h[2 * e2] = __builtin_bit_cast(float, xa[q][e2] << 16) * rs * g[2 * e2]; h[2 * e2 + 1] = __builtin_bit_cast(float, xa[q][e2] & 0xffff0000u) * rs * g[2 * e2 + 1];
                                             h[8 + 2 * e2] = __builtin_bit_cast(float, xb[q][e2] << 16) * rs * g[8 + 2 * e2]; h[8 + 2 * e2 + 1] = __builtin_bit_cast(float, xb[q][e2] & 0xffff0000u) * rs * g[8 + 2 * e2 + 1]; }
            u32x4 o;
#pragma unroll
            for (int w = 0; w < 4; ++w) { int p = __builtin_amdgcn_cvt_pk_fp8_f32(h[4 * w], h[4 * w + 1], 0, false); p = __builtin_amdgcn_cvt_pk_fp8_f32(h[4 * w + 2], h[4 * w + 3], p, true); o[w] = (unsigned)p; }
            *(u32x4*)(XQ + (size_t)m * 1024 + 16 * lane) = o; } }
    }
}
__device__ __forceinline__ void gather_um_phase(Frame& F, int l) {
    const int lane = F.lane, j = (int)(blockIdx.x & 7), wg = (int)(blockIdx.x >> 3), nwg = F.G >> 3, es = lane >> 3, c8 = lane & 7, m = lane & 15, c = lane >> 4;
    const unsigned short* ids = wsp<unsigned short>(F, WS_IDS);
    const unsigned char* U8 = F.ws + WS_UB + l * UB_L + (size_t)j * (16384 * 128) + 16 * c8; const unsigned char* XQ = F.ws + WS_XQ + 128 * j + 8 * c;
    bf16_t* PARTB = wsp<bf16_t>(F, WS_PART) + (size_t)j * M * 128;
    LAS unsigned char* img = F.lds + F.wave * 16384;
    LAS unsigned char* wr0 = img + es * 128 + ((c8 ^ (es >> 1)) << 4), * wr1 = img + es * 128 + ((c8 ^ ((es >> 1) | 4)) << 4);
    const int msw = (m >> 1) & 7; const LAS unsigned char* rd = img + m * 128 + (c & 1) * 8;
    const int t0 = wg * NWAVES + F.wave, tstep = nwg * NWAVES, ntok = (M - t0 + tstep - 1) / tstep;
#define GM_IDS(dst, tt) do { const unsigned short* ip_ = ids + (size_t)(tt) * 128 + 8 * es; dst[0] = *(const u32x4*)ip_; dst[1] = *(const u32x4*)(ip_ + 64); } while (0)
#define GM_ROWS(dst, idv_) do { _Pragma("unroll") for (int i = 0; i < 16; ++i) dst[i] = *(const u32x4*)(U8 + (size_t)(((i >> 1) & 1) ? (idv_[i & 1][i >> 2] >> 16) : (idv_[i & 1][i >> 2] & 0xffffu)) * 128); } while (0)
#define GM_X(dst, tt) do { _Pragma("unroll") for (int s_ = 0; s_ < 4; ++s_) dst[s_] = *(const u32x2*)(XQ + (size_t)(tt) * 1024 + 32 * s_); } while (0)
#define GM_PK(v_) ((long)(((unsigned long long)(v_)[1] << 32) | (unsigned long long)(v_)[0]))
    u32x4 idn[2], rA[16], rB[16]; u32x2 xA[4], xB[4];
    { u32x4 id0[2]; GM_IDS(id0, t0); GM_ROWS(rA, id0); GM_X(xA, t0); GM_IDS(idn, (ntok > 1 ? t0 + tstep : t0)); }
#define GM_BODY(CUR, NXT, XC, XNX, kk) do { const int t = t0 + (kk) * tstep; \
        GM_ROWS(NXT, idn); GM_X(XNX, (((kk) + 1 < ntok) ? t + tstep : t)); \
        { const int t2 = ((kk) + 2 < ntok) ? t + 2 * tstep : t; GM_IDS(idn, t2); } \
        _Pragma("unroll") for (int i = 0; i < 16; ++i) *(LAS u32x4*)(((i & 1) ? wr1 : wr0) + 1024 * i) = CUR[i]; \
        f32x4 d[8]; \
        _Pragma("unroll") for (int g = 0; g < 8; ++g) { f32x4 a_ = (f32x4){0.f, 0.f, 0.f, 0.f}; \
            _Pragma("unroll") for (int s_ = 0; s_ < 4; ++s_) { const u32x2 av_ = *(const LAS u32x2*)(rd + 2048 * g + (((2 * s_ + (c >> 1)) ^ msw) << 4)); \
                a_ = __builtin_amdgcn_mfma_f32_16x16x32_fp8_fp8(GM_PK(av_), GM_PK(XC[s_]), a_, 0, 0, 0); } \
            d[g] = a_; } \
        if (m == 0) { bf16_t* dst = PARTB + (size_t)t * 128 + 32 * c; const float SC = 1.0f / 512.0f; \
            _Pragma("unroll") for (int i = 0; i < 4; ++i) *(u32x4*)(dst + 8 * i) = (u32x4){cvt_pk(d[0][i] * SC, d[1][i] * SC), cvt_pk(d[2][i] * SC, d[3][i] * SC), cvt_pk(d[4][i] * SC, d[5][i] * SC), cvt_pk(d[6][i] * SC, d[7][i] * SC)}; } } while (0)
#pragma unroll 1
    for (int k = 0; k < ntok; k += 2) { GM_BODY(rA, rB, xA, xB, k); if (k + 1 < ntok) GM_BODY(rB, rA, xB, xA, k + 1); }
#undef GM_BODY
#undef GM_IDS
#undef GM_ROWS
#undef GM_X
#undef GM_PK
}
__device__ __forceinline__ void gather_vm_phase(Frame& F, int l) {
    const int lane = F.lane, j = (int)(blockIdx.x & 7), wg = (int)(blockIdx.x >> 3), nwg = F.G >> 3, es = lane >> 3, c8 = lane & 7, n = lane & 15, c = lane >> 4;
    const unsigned short* ids = wsp<unsigned short>(F, WS_IDS); const unsigned char* AHL = F.ws + ((n & 1) ? WS_AL : WS_AH) + 8 * c;
    const unsigned char* V8 = F.ws + WS_VB + l * UB_L + (size_t)j * (16384 * 128) + 16 * c8;
    const int dwi = (n & 1) ? 16 * c + 8 + (n >> 1) : 16 * c + (n >> 1);
    const bf16_t* X1B = wsp<bf16_t>(F, WS_X1B) + 128 * j + 2 * dwi; bf16_t* XN = wsp<bf16_t>(F, WS_XN) + 128 * j + 2 * dwi; float* SSQ2 = wsp<float>(F, WS_SSQ2);
    LAS unsigned char* img = F.lds + F.wave * 16384;
    LAS unsigned char* wr = img + es * 2048;
    const int r = n >> 1, rsw = ((c & 1) << 2) | (r >> 1); const LAS unsigned char* rd = img + (8 * c + r) * 128 + 8 * (n & 1);
    const int t0 = wg * NWAVES + F.wave, tstep = nwg * NWAVES, ntok = (M - t0 + tstep - 1) / tstep;
#define VM_IDS(dst, tt) do { _Pragma("unroll") for (int w = 0; w < 2; ++w) dst[w] = *(const u32x4*)(ids + (size_t)(tt) * 128 + 16 * es + 8 * w); } while (0)
#define VM_ROWS(dst, idv_) do { _Pragma("unroll") for (int i = 0; i < 16; ++i) dst[i] = *(const u32x4*)(V8 + (size_t)((i & 1) ? (idv_[i >> 3][(i >> 1) & 3] >> 16) : (idv_[i >> 3][(i >> 1) & 3] & 0xffffu)) * 128); } while (0)
#define VM_A(dh, tt) do { _Pragma("unroll") for (int s_ = 0; s_ < 4; ++s_) dh[s_] = *(const u32x2*)(AHL + (size_t)(tt) * 128 + 32 * s_); } while (0)
#define VM_PK(v_) ((long)(((unsigned long long)(v_)[1] << 32) | (unsigned long long)(v_)[0]))
    u32x4 idn[2], rA[16], rB[16]; u32x2 hA[4], hB[4];
    { u32x4 id0[2]; VM_IDS(id0, t0); VM_ROWS(rA, id0); VM_A(hA, t0); VM_IDS(idn, (ntok > 1 ? t0 + tstep : t0)); }
#define VM_BODY(CUR, NXT, HC, HN, kk) do { const int t = t0 + (kk) * tstep; \
        VM_ROWS(NXT, idn); VM_A(HN, (((kk) + 1 < ntok) ? t + tstep : t)); \
        { const int t2 = ((kk) + 2 < ntok) ? t + 2 * tstep : t; VM_IDS(idn, t2); } \
        const unsigned x1w = *(const unsigned*)(X1B + (size_t)t * D); \
        _Pragma("unroll") for (int i = 0; i < 16; ++i) *(LAS u32x4*)(wr + 128 * i + ((c8 ^ ((i >> 1) & 7)) << 4)) = CUR[i]; \
        float d[8]; \
        _Pragma("unroll") for (int b_ = 0; b_ < 8; ++b_) { f32x4 a_ = (f32x4){0.f, 0.f, 0.f, 0.f}; \
            _Pragma("unroll") for (int s_ = 0; s_ < 4; ++s_) { const v2i32_t bv_ = __builtin_amdgcn_ds_read_tr8_b64_v2i32((LAS v2i32_t*)(rd + 4096 * s_ + ((b_ ^ rsw) << 4))); \
                a_ = __builtin_amdgcn_mfma_f32_16x16x32_fp8_fp8(VM_PK(HC[s_]), __builtin_bit_cast(long, bv_), a_, 0, 0, 0); } \
            d[b_] = a_[0] + a_[1]; } \
        const float vA = c == 0 ? d[0] : (c == 1 ? d[2] : (c == 2 ? d[4] : d[6])), vB = c == 0 ? d[1] : (c == 1 ? d[3] : (c == 2 ? d[5] : d[7])); \
        const float sA = dpp_mov<0xB1>(vA), sB = dpp_mov<0xB1>(vB); \
        const float SCV = 1.0f / 256.0f;     \
        const float o0 = ((n & 1) ? sB : vA) * SCV + __builtin_bit_cast(float, x1w << 16), o1 = ((n & 1) ? vB : sA) * SCV + __builtin_bit_cast(float, x1w & 0xffff0000u); \
        *(unsigned*)(XN + (size_t)t * D) = cvt_pk(o0, o1); \
        float sq = o0 * o0 + o1 * o1; sq = wave_sum(sq); \
        if (lane == 0) SSQ2[(size_t)t * 8 + j] = sq; } while (0)
#pragma unroll 1
    for (int k = 0; k < ntok; k += 2) { VM_BODY(rA, rB, hA, hB, k); if (k + 1 < ntok) VM_BODY(rB, rA, hB, hA, k + 1); }
#undef VM_BODY
#undef VM_IDS
#undef VM_ROWS
#undef VM_A
#undef VM_PK
}
__device__ __forceinline__ void gather_ux_phase(Frame& F, int l) {
    const int lane = F.lane, j = (int)(blockIdx.x & 7), wg = (int)(blockIdx.x >> 3), nwg = F.G >> 3, row = lane >> 4;
    const bf16_t* X1B = wsp<bf16_t>(F, WS_X1B); const float* ssqx = wsp<float>(F, WS_SSQX); const int* ids = wsp<int>(F, WS_IDS); float* gates = wsp<float>(F, WS_GATES);
    const unsigned char* U8 = F.ws + WS_UB + l * UB_L + 16 * lane;
    float gl[16];
    { const float* gp = F.a->in[12] + (size_t)l * D + 16 * lane;
#pragma unroll
      for (int w = 0; w < 4; ++w) { const f32x4 gg = *(const f32x4*)(gp + 4 * w); gl[4 * w] = gg[0]; gl[4 * w + 1] = gg[1]; gl[4 * w + 2] = gg[2]; gl[4 * w + 3] = gg[3]; } }
    const float* rsx = wsp<float>(F, WS_RSX);
    const int t0 = wg * NWAVES + F.wave, tstep = nwg * NWAVES, ntok = (M - t0 + tstep - 1) / tstep;
    int id0 = ids[(size_t)t0 * 128 + lane], id1 = ids[(size_t)t0 * 128 + 64 + lane];
    float gt0 = gates[(size_t)t0 * 128 + lane], gt1 = gates[(size_t)t0 * 128 + 64 + lane];
    u32x4 xa = *(const u32x4*)(X1B + (size_t)t0 * D + 16 * lane), xb = *(const u32x4*)(X1B + (size_t)t0 * D + 16 * lane + 8);
    float rsv = rsx[t0];
#pragma unroll 1
    for (int k = 0; k < ntok; ++k) {
        const int t = t0 + k * tstep, tn = (k + 1 < ntok) ? t + tstep : t;
        const int nid0 = ids[(size_t)tn * 128 + lane], nid1 = ids[(size_t)tn * 128 + 64 + lane];
        const float ngt0 = gates[(size_t)tn * 128 + lane], ngt1 = gates[(size_t)tn * 128 + 64 + lane];
        const u32x4 nxa = *(const u32x4*)(X1B + (size_t)tn * D + 16 * lane), nxb = *(const u32x4*)(X1B + (size_t)tn * D + 16 * lane + 8);
        const float nrs = rsx[tn];
        unsigned long long m0 = __ballot((id0 >> 11) == j), m1 = __ballot((id1 >> 11) == j);
        float h[16];
        { const float rs = rsv * (1.0f / 64.0f);
#pragma unroll
          for (int e2 = 0; e2 < 4; ++e2) { h[2 * e2] = __builtin_bit_cast(float, xa[e2] << 16) * rs * gl[2 * e2]; h[2 * e2 + 1] = __builtin_bit_cast(float, xa[e2] & 0xffff0000u) * rs * gl[2 * e2 + 1];
                                           h[8 + 2 * e2] = __builtin_bit_cast(float, xb[e2] << 16) * rs * gl[8 + 2 * e2]; h[8 + 2 * e2 + 1] = __builtin_bit_cast(float, xb[e2] & 0xffff0000u) * rs * gl[8 + 2 * e2 + 1]; } }
        while (m0 | m1) {
            int sl[16], idk[16]; float gk[16]; int lastid = 2048 * j;
#pragma unroll
            for (int q = 0; q < 16; ++q) {
                if (m0) { const int s2 = __builtin_ctzll(m0); m0 &= m0 - 1; sl[q] = s2; idk[q] = __builtin_amdgcn_readlane(id0, s2); gk[q] = __builtin_bit_cast(float, __builtin_amdgcn_readlane(__builtin_bit_cast(int, gt0), s2)); lastid = idk[q]; }
                else if (m1) { const int s2 = __builtin_ctzll(m1); m1 &= m1 - 1; sl[q] = 64 + s2; idk[q] = __builtin_amdgcn_readlane(id1, s2); gk[q] = __builtin_bit_cast(float, __builtin_amdgcn_readlane(__builtin_bit_cast(int, gt1), s2)); lastid = idk[q]; }
                else { sl[q] = -1; idk[q] = lastid; gk[q] = 0.f; } }
            u32x4 rw[16];
#pragma unroll
            for (int q = 0; q < 16; ++q) rw[q] = *(const u32x4*)(U8 + (size_t)idk[q] * D);
#pragma unroll
            for (int gq = 0; gq < 2; ++gq) {
                if (sl[8 * gq] < 0) break;
                float p[8];
#pragma unroll
                for (int q = 0; q < 8; ++q) { float s = 0.f;
#pragma unroll
                    for (int w = 0; w < 4; ++w) { const auto lo = __builtin_amdgcn_cvt_pk_f32_fp8((int)rw[8 * gq + q][w], false), hi2 = __builtin_amdgcn_cvt_pk_f32_fp8((int)rw[8 * gq + q][w], true);
                        s = fmaf(h[4 * w], lo[0], s); s = fmaf(h[4 * w + 1], lo[1], s); s = fmaf(h[4 * w + 2], hi2[0], s); s = fmaf(h[4 * w + 3], hi2[1], s); }
                    p[q] = s; }
                float q4[4];
#pragma unroll
                for (int q = 0; q < 4; ++q) { auto rr = __builtin_amdgcn_permlane32_swap(__float_as_uint(p[2 * q]), __float_as_uint(p[2 * q + 1]), false, false); q4[q] = __uint_as_float(rr[0]) + __uint_as_float(rr[1]); }
                float t2[2];
#pragma unroll
                for (int q = 0; q < 2; ++q) { auto rr = __builtin_amdgcn_permlane16_swap(__float_as_uint(q4[2 * q]), __float_as_uint(q4[2 * q + 1]), false, false); t2[q] = __uint_as_float(rr[0]) + __uint_as_float(rr[1]); }
#pragma unroll
                for (int q = 0; q < 2; ++q) { t2[q] = row_ror_add<8>(t2[q]); t2[q] = row_ror_add<4>(t2[q]); t2[q] = row_ror_add<2>(t2[q]); t2[q] = row_ror_add<1>(t2[q]); }
                const int b8 = 8 * gq;
                const int sA = (row == 0) ? sl[b8 + 0] : (row == 1) ? sl[b8 + 2] : (row == 2) ? sl[b8 + 1] : sl[b8 + 3], sB = (row == 0) ? sl[b8 + 4] : (row == 1) ? sl[b8 + 6] : (row == 2) ? sl[b8 + 5] : sl[b8 + 7];
                const float gA = (row == 0) ? gk[b8 + 0] : (row == 1) ? gk[b8 + 2] : (row == 2) ? gk[b8 + 1] : gk[b8 + 3], gB = (row == 0) ? gk[b8 + 4] : (row == 1) ? gk[b8 + 6] : (row == 2) ? gk[b8 + 5] : gk[b8 + 7];
                if ((lane & 15) == 0) { if (sA >= 0) gates[(size_t)t * 128 + sA] = gelu1(t2[0]) * gA * 0.125f; if (sB >= 0) gates[(size_t)t * 128 + sB] = gelu1(t2[1]) * gB * 0.125f; }
            }
        }
        id0 = nid0; id1 = nid1; gt0 = ngt0; gt1 = ngt1; xa = nxa; xb = nxb; rsv = nrs;
    }
}
__device__ __forceinline__ void gather_r_phase_f32(Frame& F) {
    const int gt = (int)blockIdx.x * (NWAVES * 64) + F.tid, NT = F.G * NWAVES * 64; const float* PART = wsp<float>(F, WS_PART); float* gates = wsp<float>(F, WS_GATES);
    for (int i = gt; i < M * 32; i += NT) { f32x4 s = *(const f32x4*)(PART + (size_t)i * 4);
#pragma unroll
        for (int jj = 1; jj < 8; ++jj) s = s + *(const f32x4*)(PART + (size_t)jj * M * 128 + (size_t)i * 4);
        const f32x4 g = *(const f32x4*)(gates + (size_t)i * 4);
        *(f32x4*)(gates + (size_t)i * 4) = (f32x4){gelu1(s[0]) * g[0] * 0.125f, gelu1(s[1]) * g[1] * 0.125f, gelu1(s[2]) * g[2] * 0.125f, gelu1(s[3]) * g[3] * 0.125f}; }
}
__device__ __forceinline__ void gather_r_phase(Frame& F) {
    if (!MK_UMFMA) { gather_r_phase_f32(F); return; }
    const int gt = (int)blockIdx.x * (NWAVES * 64) + F.tid, NT = F.G * NWAVES * 64; const bf16_t* PARTB = wsp<bf16_t>(F, WS_PART); float* gates = wsp<float>(F, WS_GATES);
    for (int i = gt; i < M * 16; i += NT) { float s[8];
#pragma unroll
        for (int k = 0; k < 8; ++k) s[k] = 0.f;
#pragma unroll
        for (int jj = 0; jj < 8; ++jj) { const u32x4 v = *(const u32x4*)(PARTB + (size_t)jj * M * 128 + (size_t)i * 8);
#pragma unroll
            for (int e2 = 0; e2 < 4; ++e2) { s[2 * e2] += __builtin_bit_cast(float, v[e2] << 16); s[2 * e2 + 1] += __builtin_bit_cast(float, v[e2] & 0xffff0000u); } }
        const f32x4 g0 = *(const f32x4*)(gates + (size_t)i * 8), g1 = *(const f32x4*)(gates + (size_t)i * 8 + 4);
        if (!MK_VMFMA) {
        *(u32x4*)(wsp<bf16_t>(F, WS_AVB) + (size_t)i * 8) = (u32x4){cvt_pk(gelu1(s[0]) * g0[0] * 0.125f, gelu1(s[1]) * g0[1] * 0.125f), cvt_pk(gelu1(s[2]) * g0[2] * 0.125f, gelu1(s[3]) * g0[3] * 0.125f),
                                                                   cvt_pk(gelu1(s[4]) * g1[0] * 0.125f, gelu1(s[5]) * g1[1] * 0.125f), cvt_pk(gelu1(s[6]) * g1[2] * 0.125f, gelu1(s[7]) * g1[3] * 0.125f)};
        } else {
            float av_[8];
#pragma unroll
            for (int k = 0; k < 8; ++k) av_[k] = gelu1(s[k]) * (k < 4 ? g0[k & 3] : g1[k & 3]) * 32.0f;
            u32x2 hi_, lo_;
#pragma unroll
            for (int w = 0; w < 2; ++w) { int p = __builtin_amdgcn_cvt_pk_fp8_f32(av_[4 * w], av_[4 * w + 1], 0, false); p = __builtin_amdgcn_cvt_pk_fp8_f32(av_[4 * w + 2], av_[4 * w + 3], p, true);
                const f32x2 b0 = __builtin_amdgcn_cvt_pk_f32_fp8(p, false), b1 = __builtin_amdgcn_cvt_pk_f32_fp8(p, true);
                int q = __builtin_amdgcn_cvt_pk_fp8_f32(av_[4 * w] - b0[0], av_[4 * w + 1] - b0[1], 0, false); q = __builtin_amdgcn_cvt_pk_fp8_f32(av_[4 * w + 2] - b1[0], av_[4 * w + 3] - b1[1], q, true);
                hi_[w] = (unsigned)p; lo_[w] = (unsigned)q; }
            *(u32x2*)(F.ws + WS_AH + (size_t)i * 8) = hi_; *(u32x2*)(F.ws + WS_AL + (size_t)i * 8) = lo_; } }
}
__device__ __forceinline__ void gather_v_phase(Frame& F, int l) {
    const int lane = F.lane, j = MK_XCCJ ? (int)(xb_xcc_id() & 7u) : (int)(blockIdx.x & 7), wg = (int)(blockIdx.x >> 3), nwg = F.G >> 3, es = lane >> 3, c = lane & 7, row = lane >> 4;
    const bf16_t* X1B = wsp<bf16_t>(F, WS_X1B); const unsigned short* ids = wsp<unsigned short>(F, WS_IDS); const bf16_t* AV = wsp<bf16_t>(F, WS_AVB);
    const unsigned char* V8 = F.ws + WS_VB + l * UB_L + (size_t)j * (16384 * 128) + 16 * c; float* X2 = wsp<float>(F, WS_X2); bf16_t* XN = wsp<bf16_t>(F, WS_XN); float* SSQ2 = wsp<float>(F, WS_SSQ2);
    const int t0 = wg * NWAVES + F.wave, tstep = nwg * NWAVES, ntok = (M - t0 + tstep - 1) / tstep;
#define GV_IDS(dst, tt) do { _Pragma("unroll") for (int w = 0; w < 2; ++w) dst[w] = *(const u32x4*)(ids + (size_t)(tt) * 128 + 16 * es + 8 * w); } while (0)
#define GV_ROWS(dst, idv_) do { _Pragma("unroll") for (int i = 0; i < 16; ++i) dst[i] = *(const u32x4*)(V8 + (size_t)((i & 1) ? (idv_[i >> 3][(i >> 1) & 3] >> 16) : (idv_[i >> 3][(i >> 1) & 3] & 0xffffu)) * 128); } while (0)
    u32x4 idn[2], rA[16], rB[16];
    { u32x4 id0[2]; GV_IDS(id0, t0); GV_ROWS(rA, id0); GV_IDS(idn, (ntok > 1 ? t0 + tstep : t0)); }
#define GV_BODY(CUR, NXT, kk) do { const int t = t0 + (kk) * tstep; \
        GV_ROWS(NXT, idn); \
        { const int t2 = ((kk) + 2 < ntok) ? t + 2 * tstep : t; GV_IDS(idn, t2); } \
        u32x4 av[2]; \
        _Pragma("unroll") for (int w = 0; w < 2; ++w) av[w] = *(const u32x4*)(AV + (size_t)t * 128 + 16 * es + 8 * w); \
        const u32x2 x1b_ = *(const u32x2*)(X1B + (size_t)t * D + 128 * j + 16 * c + 4 * row); \
        const f32x4 x1v = (f32x4){__builtin_bit_cast(float, x1b_.x << 16), __builtin_bit_cast(float, x1b_.x & 0xffff0000u), __builtin_bit_cast(float, x1b_.y << 16), __builtin_bit_cast(float, x1b_.y & 0xffff0000u)}; \
        f32x2 acc2[8];                                                    \
        _Pragma("unroll") for (int e2 = 0; e2 < 8; ++e2) acc2[e2] = (f32x2){0.f, 0.f}; \
        _Pragma("unroll") for (int i = 0; i < 16; ++i) { const unsigned aw_ = av[i >> 3][(i >> 1) & 3]; const float a = __builtin_bit_cast(float, (i & 1) ? (aw_ & 0xffff0000u) : (aw_ << 16)); const f32x2 a2 = (f32x2){a, a}; \
            _Pragma("unroll") for (int w = 0; w < 4; ++w) { const f32x2 lo = __builtin_amdgcn_cvt_pk_f32_fp8((int)CUR[i][w], false), hi2 = __builtin_amdgcn_cvt_pk_f32_fp8((int)CUR[i][w], true); \
                acc2[2 * w] = __builtin_elementwise_fma(a2, lo, acc2[2 * w]); acc2[2 * w + 1] = __builtin_elementwise_fma(a2, hi2, acc2[2 * w + 1]); } } \
        float acc[16]; \
        _Pragma("unroll") for (int e2 = 0; e2 < 8; ++e2) { acc[2 * e2] = acc2[e2][0]; acc[2 * e2 + 1] = acc2[e2][1]; } \
        float v8[8]; \
        _Pragma("unroll") for (int m = 0; m < 8; ++m) { auto rr = __builtin_amdgcn_permlane32_swap(__float_as_uint(acc[m]), __float_as_uint(acc[m + 8]), false, false); v8[m] = __uint_as_float(rr[0]) + __uint_as_float(rr[1]); } \
        float v4[4]; \
        _Pragma("unroll") for (int m = 0; m < 4; ++m) { auto rr = __builtin_amdgcn_permlane16_swap(__float_as_uint(v8[m]), __float_as_uint(v8[m + 4]), false, false); v4[m] = __uint_as_float(rr[0]) + __uint_as_float(rr[1]); } \
        _Pragma("unroll") for (int m = 0; m < 4; ++m) v4[m] = row_ror_add<8>(v4[m]); \
        const f32x4 x2v = (f32x4){x1v[0] + v4[0], x1v[1] + v4[1], x1v[2] + v4[2], x1v[3] + v4[3]}; \
        float sq = 0.f; \
        if ((lane & 8) == 0) { const size_t off = (size_t)t * D + 128 * j + 16 * c + 4 * row; \
            u32x2 w2; w2.x = cvt_pk(x2v[0], x2v[1]); w2.y = cvt_pk(x2v[2], x2v[3]); *(u32x2*)(XN + off) = w2; \
            sq = (x2v[0] * x2v[0] + x2v[1] * x2v[1]) + (x2v[2] * x2v[2] + x2v[3] * x2v[3]); } \
        sq = wave_sum(sq); \
        if (lane == 0) SSQ2[(size_t)t * 8 + j] = sq; } while (0)
#pragma unroll 1
    for (int k = 0; k < ntok; k += 2) { GV_BODY(rA, rB, k); if (k + 1 < ntok) GV_BODY(rB, rA, k + 1); }
#undef GV_BODY
#undef GV_IDS
#undef GV_ROWS
}
__device__ __forceinline__ void final_phase(Frame& F) {
    const int gw = F.vcu * NWAVES + F.wave, NGW = F.G * NWAVES, lane = F.lane; const bf16_t* XN = wsp<bf16_t>(F, WS_XN); const float* SSQ2 = wsp<float>(F, WS_SSQ2); const float* fg = F.a->in[18]; float* O = F.a->out;
    f32x4 gg[4];
#pragma unroll
    for (int w = 0; w < 4; ++w) gg[w] = *(const f32x4*)(fg + 256 * w + 4 * lane);
    for (int t0 = gw; t0 < M; t0 += 8 * NGW) {
        u32x2 xv[8][4]; f32x4 sa[8], sb[8];
#pragma unroll
        for (int k = 0; k < 8; ++k) { const int t = t0 + k * NGW; if (t < M) { sa[k] = *(const f32x4*)(SSQ2 + (size_t)t * 8); sb[k] = *(const f32x4*)(SSQ2 + (size_t)t * 8 + 4);
#pragma unroll
            for (int w = 0; w < 4; ++w) xv[k][w] = __builtin_nontemporal_load((const u32x2*)(XN + (size_t)t * D + 256 * w + 4 * lane)); } }
#pragma unroll
        for (int k = 0; k < 8; ++k) { const int t = t0 + k * NGW; if (t < M) { const f32x4 a = sa[k], b = sb[k];
            const float r2 = 1.0f / sqrtf((((a[0] + a[1]) + (a[2] + a[3])) + ((b[0] + b[1]) + (b[2] + b[3]))) * (1.f / D) + EPS);
#pragma unroll
            for (int w = 0; w < 4; ++w) { const u32x2 v = xv[k][w]; const float x0 = __builtin_bit_cast(float, v.x << 16), x1 = __builtin_bit_cast(float, v.x & 0xffff0000u), x2 = __builtin_bit_cast(float, v.y << 16), x3 = __builtin_bit_cast(float, v.y & 0xffff0000u);
                *(f32x4*)(O + (size_t)t * D + 256 * w + 4 * lane) = (f32x4){x0 * r2 * gg[w][0], x1 * r2 * gg[w][1], x2 * r2 * gg[w][2], x3 * r2 * gg[w][3]}; } } }
    }
}
}

namespace fx {
#ifndef MK_GSLICE
#define MK_GSLICE 1
#endif
constexpr int PPL = MK_GSLICE ? (MK_UEXP ? 7 : 8) : 6;
constexpr int N_PHASES = 2 + 2 * PPL - (MK_GSLICE ? 0 : 1);
#ifndef MK_DBGQ
#define MK_DBGQ 0
#endif
#ifndef MK_MASK
#define MK_MASK 255
#endif
#ifndef PG8_SP2
#define PG8_SP2 true
#endif
#ifndef PG8_ALIGN
#define PG8_ALIGN true
#endif

typedef const __attribute__((address_space(4))) Args* ArgsK;
__device__ __forceinline__ void make_frame(Frame& F, unsigned char* lds) {
    ArgsK kp = (ArgsK)__builtin_amdgcn_kernarg_segment_ptr(); asm volatile("" : "+s"(kp));
    int tid = threadIdx.x; asm volatile("" : "+v"(tid));
    F.lds = (LAS unsigned char*)lds; F.MISC = (volatile LAS unsigned*)(F.lds + MISC_OFF);
    F.tid = tid; F.lane = tid & 63; F.wave = __builtin_amdgcn_readfirstlane(tid >> 6);
    F.G = gridDim.x; { const int bx = blockIdx.x; F.vcu = (F.G % 8 == 0) ? (bx % 8) * (F.G / 8) + bx / 8 : bx; }
    F.a = kp; F.ws = kp->ws; F.ctl = (gu32*)(F.ws + WS_CTL);
}
template <int ph> __device__ __forceinline__ void run_phase(unsigned char* lds) {
    Frame F; make_frame(F, lds);
    ArgsK A = F.a;
    if (ph == 0) { if (MK_MASK & 128) p0_prologue(F, A->pad & 15); return; }
    if (MK_GSLICE && ph == N_PHASES - 1) { final_phase(F); return; }
    constexpr int l = (ph - 1) / PPL, s = (ph - 1) % PPL;
    if (s == 0 && (MK_MASK & 1)) {
        pg8::Gemm g{wsp<bf16_t>(F, WS_XN), wsp<bf16_t>(F, WS_WIN + l * WIN_L), M, NP, D, D, D}; pg8::StaticOrder S; S.init(M, NP, F.G, (int)blockIdx.x);
        EpiG1 E{wsp<bf16_t>(F, WS_PROJ), wsp<float>(F, WS_FLOG), wsp<float>(F, WS_SSQQ), wsp<float>(F, WS_SSQKV), wsp<float>(F, WS_SSQ2)};
        pg8::gemm_phase<EpiG1, pg8::StaticOrder, PG8_ALIGN, PG8_SP2>(F.lds, g, S, E);
    } else if (s == 1 && (MK_MASK & 2)) {
        if (!(MK_MASK & 256)) prep_phase(F, l);
        int kmla = 384; asm volatile("" : "+s"(kmla));
        pg8::Gemm g{wsp<bf16_t>(F, WS_PROJ) + PC_CQ, wsp<bf16_t>(F, WS_WMLA + l * WMLA_L), M, 1024, kmla, NP, 384}; pg8::StaticOrder S; S.init(M, 1024, F.G, (int)blockIdx.x);
        const float* ct = wsp<float>(F, WS_ROPE);
        LAS float* fac = (LAS float*)(F.lds + FAC_OFF);
        EpiMla E{wsp<bf16_t>(F, WS_QUP), wsp<bf16_t>(F, WS_KVUP), wsp<float>(F, WS_SSQQ), wsp<float>(F, WS_SSQKV), ct, ct + 2048 * 16, (const LAS float*)fac};
        { pg8::Unit u; if (S.next(0, u)) E.rs_prelude(u, F.tid, fac); }
        __syncthreads();
        pg8::gemm_phase<EpiMla, pg8::StaticOrder, PG8_ALIGN, PG8_SP2>(F.lds, g, S, E);
    } else if (s == 2 && (MK_MASK & 4)) {
        attn_phase(F, l);
    } else if (s == 3 && (MK_MASK & 8)) {
        pg8::Gemm g{wsp<bf16_t>(F, WS_Y), wsp<bf16_t>(F, WS_WOUT + l * WOUT_L), M, D, D, D, D}; pg8::StaticOrder S; S.init(M, D, F.G, (int)blockIdx.x);
        pg8::Unit u; LAS float* fac = (LAS float*)(F.lds + FAC_OFF);
        if (S.next(0, u) && F.tid < 256) { const int row = u.pm * 256 + F.tid; const float* sp = wsp<float>(F, WS_SSQH) + (size_t)row * 16;
            const float s1 = ((sp[0] + sp[1]) + (sp[2] + sp[3])) + (sp[4] + sp[5]), s2 = (sp[6] + sp[7]) + (sp[8] + sp[9]), s3 = ((sp[10] + sp[11]) + (sp[12] + sp[13])) + (sp[14] + sp[15]);
            const float r1 = 1.0f / sqrtf(s1 * (1.f / 384.f) + EPS), r2 = 1.0f / sqrtf(s2 * (1.f / 256.f) + EPS), r3 = 1.0f / sqrtf(s3 * (1.f / 384.f) + EPS);
            fac[F.tid] = r1 / r2; fac[256 + F.tid] = r2 / r3; fac[512 + F.tid] = r3; }
        __syncthreads();
        EpiWout E{(const LAS float*)fac, wsp<bf16_t>(F, WS_XN), wsp<bf16_t>(F, WS_X1B), wsp<float>(F, WS_SSQX)};
        pg8::gemm_phase<EpiWout, pg8::StaticOrder, false, PG8_SP2>(F.lds, g, S, E);
    } else if (s == 4 && (MK_MASK & 16)) {
        if (MK_UMFMA) xq_pass(F, l);
        pg8::Gemm g{wsp<bf16_t>(F, WS_X1B), wsp<bf16_t>(F, WS_WQ + l * WQ_L), M, 2048, D, D, D};
        LAS float* fac = (LAS float*)(F.lds + FAC_OFF);
        EpiQ E{wsp<float>(F, WS_SSQX), wsp<bf16_t>(F, WS_KEYS) + (size_t)l * 65536, wsp<unsigned short>(F, WS_IDS), wsp<float>(F, WS_GATES), (MK_DBGQ ? wsp<float>(F, WS_QF) : nullptr), wsp<float>(F, WS_RSX), (const LAS float*)fac};
#pragma unroll 1
        for (int r = 0; r < 2; ++r) { OneUnit S; S.S.init(M, 2048, F.G, (int)blockIdx.x); S.i = r;
            pg8::Unit u; if (S.S.next(r, u)) E.rs_prelude(u, F.tid, fac);
            __syncthreads();
            pg8::gemm_phase<EpiQ, OneUnit, false, PG8_SP2>(F.lds, g, S, E); }
    } else if (MK_GSLICE && MK_UEXP && s == 5) { gather_ux_phase(F, l);
    } else if (MK_GSLICE && MK_UEXP && s == 6) { gather_v_phase(F, l);
    } else if (MK_GSLICE && !MK_UEXP && s == 5) { if (MK_UMFMA) gather_um_phase(F, l); else gather_u_phase(F, l);
    } else if (MK_GSLICE && !MK_UEXP && s == 6) { gather_r_phase(F);
    } else if (MK_GSLICE && !MK_UEXP && s == 7) { if (MK_VMFMA) gather_vm_phase(F, l); else gather_v_phase(F, l);
    } else if (!MK_GSLICE && s == 5 && (MK_MASK & 64)) {
        gather_phase(F, l);
    }
}

template <int PH> __device__ __forceinline__ void run_all(unsigned char* lds, int lo, int hi) {
    if constexpr (PH < N_PHASES) {
        if (lo <= PH && PH < hi) {
            run_phase<PH>(lds);
            if (PH + 1 < hi) { Frame F; make_frame(F, lds); XcdBarrier bar; bar.bar = (unsigned*)(F.ctl + CW_BAR) + F.a->li * XCD_BAR_WORDS; bar.x = xb_xcc_id(); bar.st = F.MISC + 8; xcd_barrier(bar); }
        }
        run_all<PH + 1>(lds, lo, hi);
    }
}
__global__ void __launch_bounds__(NWAVES * 64, 2) mk_fwd(Args args) {
    extern __shared__ __attribute__((aligned(16))) unsigned char lds[];
    for (int u = threadIdx.x; u < (LDS_BYTES - LDSCTL_OFF) / 4; u += NWAVES * 64) ((LAS unsigned*)((LAS unsigned char*)lds + LDSCTL_OFF))[u] = 0u;
    __syncthreads();
    const int lo = args.ph_lo, hi = args.ph_hi;
    if (hi - lo > 1) (void)xcd_barrier_post((unsigned*)(args.ws + WS_CTL) + CW_BAR + args.li * XCD_BAR_WORDS, (volatile LAS unsigned*)((LAS unsigned char*)lds + MISC_OFF) + 8);
    run_all<0>(lds, lo, hi);
}

static int g_grid = 0;
static bool host_init() {
    if (g_grid != 0) return g_grid > 0;
    int dev = 0, cus = 0;
    if (hipGetDevice(&dev) != hipSuccess || hipDeviceGetAttribute(&cus, hipDeviceAttributeMultiprocessorCount, dev) != hipSuccess) { g_grid = -1; return false; }
    if (hipFuncSetAttribute((const void*)mk_fwd, hipFuncAttributeMaxDynamicSharedMemorySize, LDS_BYTES) != hipSuccess) { g_grid = -1; return false; }
    int per_cu = 0; (void)hipOccupancyMaxActiveBlocksPerMultiprocessor(&per_cu, (const void*)mk_fwd, NWAVES * 64, LDS_BYTES); (void)hipGetLastError();
    if (cus != 256 || per_cu < 1) { fprintf(stderr, "fast path needs 256 CUs (got %d), occupancy %d\n", cus, per_cu); g_grid = -1; return false; }
    g_grid = cus; return true;
}
static void zero_ctl(void* d_ws, hipStream_t st) { (void)hipMemsetAsync((char*)d_ws + WS_CTL, 0, CTL_ZERO_BYTES, st); }
static void launch(void* const* d_in, void* d_out, void* d_ws, int lo, int hi, int li, int parts, hipStream_t st) {
    Args a{}; for (int i = 0; i < 19; ++i) a.in[i] = (const float*)d_in[i];
    a.out = (float*)d_out; a.ws = (unsigned char*)d_ws; a.ph_lo = lo; a.ph_hi = hi; a.li = li; a.pad = parts;
    hipLaunchKernelGGL(mk_fwd, dim3(g_grid), dim3(NWAVES * 64), LDS_BYTES, st, a);
}
}

extern "C" void kernel_launch(void* const* d_in, const int* in_sizes, int n_in, void* d_out, int out_size, void* d_ws, size_t ws_size, hipStream_t stream) {
    if (!fx::host_init()) { nv::forward(d_in, (float*)d_out, (unsigned char*)d_ws, 0, stream); return; }
    fx::zero_ctl(d_ws, stream);
    fx::launch(d_in, d_out, d_ws, 0, fx::N_PHASES, 0, 7, stream);
}
```
